# Optimizing an MI355X kernel written in HIP

```python
import math
import jax, jax.numpy as jnp
from jax import lax
import numpy as np

D_MODEL = 1024
BATCH = 8
SEQ = 8192
DEPTH = 1

RET_HEADS = 4
RET_DK = 64
RET_DV = 128
RET_QK = RET_HEADS * RET_DK
RET_V = RET_HEADS * RET_DV
CHUNK = 128
FOX_HEADS = 8
FOX_DH = 64
FOX_W = FOX_HEADS * FOX_DH
Q_BLOCK = 128
D_FF = -(-8 * D_MODEL // (3 * 256)) * 256
ROPE_BASE = 10000.0
EPS = 1e-6
IN_SIZES = (RET_QK, RET_QK, RET_V, RET_V, FOX_W, FOX_W, FOX_W, FOX_HEADS, D_MODEL, D_MODEL)
IN_COLS = sum(IN_SIZES)

kernel_name = "hybrid_retention_fox_gated_block"


def rmsnorm(x, g):
    xf = x.astype(jnp.float32)
    y = xf * lax.rsqrt(jnp.mean(xf * xf, axis=-1, keepdims=True) + EPS)
    return (y * g.astype(jnp.float32)).astype(x.dtype)


def rotary(x, pos):
    half = x.shape[-1] // 2
    inv_freq = 1.0 / (ROPE_BASE ** (jnp.arange(half, dtype=jnp.float32) / half))
    ang = pos[:, None] * inv_freq[None, :]
    cos = jnp.cos(ang)[None, :, None, :]
    sin = jnp.sin(ang)[None, :, None, :]
    xf = x.astype(jnp.float32)
    x1, x2 = xf[..., :half], xf[..., half:]
    return jnp.concatenate([x1 * cos - x2 * sin, x1 * sin + x2 * cos], axis=-1)


def retention_chunkwise(q, k, v):
    B, S, H, dk = q.shape
    dv = v.shape[-1]
    n = S // CHUNK
    log_g = jnp.log1p(-(2.0 ** (-5.0 - jnp.arange(H, dtype=jnp.float32))))
    qc = q.astype(jnp.float32).reshape(B, n, CHUNK, H, dk)
    kc = k.astype(jnp.float32).reshape(B, n, CHUNK, H, dk)
    vc = v.astype(jnp.float32).reshape(B, n, CHUNK, H, dv)
    idx = jnp.arange(CHUNK, dtype=jnp.float32)
    diff = idx[:, None] - idx[None, :]
    decay = jnp.where(diff[None] >= 0, jnp.exp(jnp.maximum(diff, 0.0)[None] * log_g[:, None, None]), 0.0)
    scores = jnp.einsum('bnihd,bnjhd->bnhij', qc, kc) * decay[None, None]
    intra = jnp.einsum('bnhij,bnjhe->bnihe', scores, vc)
    zeta = jnp.exp((CHUNK - 1.0 - idx)[None, :] * log_g[:, None])
    chunk_kv = jnp.einsum('bnjhd,hj,bnjhe->bnhde', kc, zeta, vc)
    g_chunk = jnp.exp(CHUNK * log_g)[:, None, None]

    def step(r_prev, kv):
        return g_chunk * r_prev + kv, r_prev

    r0 = jnp.zeros((B, H, dk, dv), jnp.float32)
    _, states = lax.scan(step, r0, jnp.moveaxis(chunk_kv, 1, 0))
    states = jnp.moveaxis(states, 0, 1)
    xi = jnp.exp((idx + 1.0)[None, :] * log_g[:, None]).T
    inter = jnp.einsum('bnihd,bnhde->bnihe', qc, states) * xi[None, None, :, :, None]
    return (intra + inter).reshape(B, S, H, dv)


def forgetting_attention(q, k, v, log_f):
    B, S, H, d = q.shape
    nb = S // Q_BLOCK
    scale = 1.0 / math.sqrt(d)
    c = jnp.cumsum(log_f, axis=1).transpose(0, 2, 1)
    qh = q.transpose(0, 2, 1, 3)
    kh = k.transpose(0, 2, 1, 3)
    vh = v.transpose(0, 2, 1, 3)
    qb = qh.reshape(B, H, nb, Q_BLOCK, d).transpose(2, 0, 1, 3, 4)
    cb = c.reshape(B, H, nb, Q_BLOCK).transpose(2, 0, 1, 3)
    pos_k = jnp.arange(S)

    def block(args):
        i, q_blk, c_blk = args
        s = jnp.einsum('bhqd,bhkd->bhqk', q_blk, kh).astype(jnp.float32) * scale
        s = s + c_blk[..., None] - c[:, :, None, :]
        pos_q = i * Q_BLOCK + jnp.arange(Q_BLOCK)
        mask = pos_k[None, :] <= pos_q[:, None]
        s = jnp.where(mask[None, None], s, -jnp.inf)
        p = jax.nn.softmax(s, axis=-1)
        return jnp.einsum('bhqk,bhkd->bhqd', p.astype(vh.dtype), vh)

    out = lax.map(block, (jnp.arange(nb), qb, cb))
    return out.transpose(1, 2, 0, 3, 4).reshape(B, H, S, d).transpose(0, 2, 1, 3)


def split_cols(z):
    offs = np.cumsum(np.array(IN_SIZES))[:-1].tolist()
    return jnp.split(z, offs, axis=-1)


def setup_inputs(seed: int = 0) -> dict:
    key = jax.random.key(seed)
    ks = jax.random.split(key, 16)
    f32 = jnp.float32
    nrm = lambda k, shp: jax.random.normal(k, shp, f32)
    L = DEPTH
    return {
        "x": nrm(ks[0], (BATCH, SEQ, D_MODEL)),
        "g_mix": 1.0 + 0.02 * nrm(ks[1], (L, D_MODEL)),
        "w_in": nrm(ks[2], (L, D_MODEL, IN_COLS)) * D_MODEL ** -0.5,
        "b_forget": 1.0 + 0.5 * nrm(ks[3], (L, FOX_HEADS)),
        "g_ret_norm": 1.0 + 0.02 * nrm(ks[4], (L, RET_V)),
        "w_ret_o": nrm(ks[5], (L, RET_V, D_MODEL)) * RET_V ** -0.5,
        "g_fox_q": 1.0 + 0.02 * nrm(ks[6], (L, FOX_DH)),
        "g_fox_k": 1.0 + 0.02 * nrm(ks[7], (L, FOX_DH)),
        "w_fox_o": nrm(ks[8], (L, FOX_W, D_MODEL)) * FOX_W ** -0.5,
        "w_out": nrm(ks[9], (L, D_MODEL, D_MODEL)) * D_MODEL ** -0.5,
        "g_ffn": 1.0 + 0.02 * nrm(ks[10], (L, D_MODEL)),
        "w_gate": nrm(ks[11], (L, D_MODEL, D_FF)) * D_MODEL ** -0.5,
        "w_up": nrm(ks[12], (L, D_MODEL, D_FF)) * D_MODEL ** -0.5,
        "w_down": nrm(ks[13], (L, D_FF, D_MODEL)) * D_FF ** -0.5,
    }


def reference(x, g_mix, w_in, b_forget, g_ret_norm, w_ret_o, g_fox_q, g_fox_k, w_fox_o,
              w_out, g_ffn, w_gate, w_up, w_down):
    B, S, _ = x.shape
    pos = jnp.arange(S, dtype=jnp.float32)
    for l in range(DEPTH):
        h = rmsnorm(x, g_mix[l])
        z = h @ w_in[l]
        q_r, k_r, v_r, gt_r, q_f, k_f, v_f, f_f, a_r, a_f = split_cols(z)

        q_r = rotary(q_r.reshape(B, S, RET_HEADS, RET_DK), pos)
        k_r = rotary(k_r.reshape(B, S, RET_HEADS, RET_DK), pos) * (RET_DK ** -0.5)
        v_r = v_r.reshape(B, S, RET_HEADS, RET_DV)
        o_r = retention_chunkwise(q_r, k_r, v_r)
        mu = jnp.mean(o_r, axis=-1, keepdims=True)
        var = jnp.mean(jnp.square(o_r - mu), axis=-1, keepdims=True)
        o_r = ((o_r - mu) * lax.rsqrt(var + EPS)).reshape(B, S, RET_V) * g_ret_norm[l].astype(jnp.float32)
        o_r = (jax.nn.silu(gt_r.astype(jnp.float32)) * o_r).astype(x.dtype)
        y_r = o_r @ w_ret_o[l]

        q_f = rmsnorm(q_f.reshape(B, S, FOX_HEADS, FOX_DH), g_fox_q[l])
        k_f = rmsnorm(k_f.reshape(B, S, FOX_HEADS, FOX_DH), g_fox_k[l])
        v_f = v_f.reshape(B, S, FOX_HEADS, FOX_DH)
        log_f = jax.nn.log_sigmoid(f_f.astype(jnp.float32) + b_forget[l].astype(jnp.float32))
        o_f = forgetting_attention(q_f, k_f, v_f, log_f).reshape(B, S, FOX_W).astype(x.dtype)
        y_f = o_f @ w_fox_o[l]

        merged = (jax.nn.sigmoid(a_r.astype(jnp.float32)) * y_r.astype(jnp.float32)
                  + jax.nn.sigmoid(a_f.astype(jnp.float32)) * y_f.astype(jnp.float32)).astype(x.dtype)
        x = x + merged @ w_out[l]

        h2 = rmsnorm(x, g_ffn[l])
        ff = (jax.nn.silu(h2 @ w_gate[l]) * (h2 @ w_up[l])) @ w_down[l]
        x = x + ff
    return x
```

```cpp
#include <hip/hip_runtime.h>
#include <hip/hip_cooperative_groups.h>
#include <cstdio>
#include <cstdint>
namespace cg = cooperative_groups;

#ifndef MK_N_LAUNCHES
#define MK_N_LAUNCHES 1
#endif

#define LAS __attribute__((address_space(3)))
typedef unsigned short bf16_t;
typedef short bf16x8 __attribute__((ext_vector_type(8)));
typedef short s16x4 __attribute__((ext_vector_type(4)));
typedef float f32x4 __attribute__((ext_vector_type(4)));
typedef float f32x2 __attribute__((ext_vector_type(2)));
typedef float f32x16 __attribute__((ext_vector_type(16)));
typedef unsigned u32x4 __attribute__((ext_vector_type(4)));
typedef unsigned u32x2 __attribute__((ext_vector_type(2)));

constexpr int M = 65536, DM = 1024, SEQ = 8192, NBATCH = 8;
constexpr int ZP = 5120;
constexpr int QR_OFF = 0, KR_OFF = 256, VR_OFF = 512, GR_OFF = 1024, QF_OFF = 1536, KF_OFF = 2048, VF_OFF = 2560, AR_OFF = 3072, AF_OFF = 4096;
constexpr int INC = 5128;
constexpr int DFF = 2816;
constexpr float EPS = 1e-6f;
constexpr float LOG2E = 1.4426950408889634f;
constexpr float C2 = 0.125f * LOG2E;

constexpr size_t MiB = 1u << 20;
constexpr size_t WS_WIN = 0, WS_WCAT = 10 * MiB, WS_WOUT = 12 * MiB, WS_WGU = 14 * MiB, WS_WDN = 25 * MiB;
constexpr size_t WS_ROPE = 31 * MiB, WS_LOGF = 33 * MiB, WS_C2 = 35 * MiB, WS_SSQ = 37 * MiB;
constexpr size_t WS_Z = 48 * MiB;
constexpr size_t WS_A = 688 * MiB;
constexpr size_t WS_B = 816 * MiB;
constexpr size_t WS_END = 944 * MiB;
constexpr int LDS_BYTES = 147456;

__device__ __forceinline__ unsigned cvtpk(float lo, float hi) { typedef __bf16 b2 __attribute__((ext_vector_type(2))); f32x2 v = {lo, hi}; b2 b = __builtin_convertvector(v, b2); return __builtin_bit_cast(unsigned, b); }
__device__ __forceinline__ float bflo(unsigned w) { return __uint_as_float(w << 16); }
__device__ __forceinline__ float bfhi(unsigned w) { return __uint_as_float(w & 0xffff0000u); }
__device__ __forceinline__ float wave_sum(float v) {
#pragma unroll
    for (int o = 1; o < 64; o <<= 1) v += __shfl_xor(v, o);
    return v;
}
__device__ __forceinline__ float sigmoidf_(float v) { return 1.f / (1.f + __expf(-v)); }
__device__ __forceinline__ int crow(int r, int hi) { return (r & 3) + 8 * (r >> 2) + 4 * hi; }
#define MFMA32(a, b, c) __builtin_amdgcn_mfma_f32_32x32x16_bf16((a), (b), (c), 0, 0, 0)
typedef short v4i16_t __attribute__((ext_vector_type(4)));
__device__ __forceinline__ s16x4 vtr(const LAS unsigned char* p) { return __builtin_bit_cast(s16x4, __builtin_amdgcn_ds_read_tr16_b64_v4i16((LAS v4i16_t*)p)); }
__device__ __forceinline__ bf16x8 cat8(s16x4 lo, s16x4 hi) { return (bf16x8){lo[0], lo[1], lo[2], lo[3], hi[0], hi[1], hi[2], hi[3]}; }
__device__ __forceinline__ bf16x8 pack8(const f32x16& x, int b) {
    u32x4 p; p[0] = cvtpk(x[b], x[b + 1]); p[1] = cvtpk(x[b + 2], x[b + 3]); p[2] = cvtpk(x[b + 4], x[b + 5]); p[3] = cvtpk(x[b + 6], x[b + 7]);
    return __builtin_bit_cast(bf16x8, p);
}

namespace pg8 {
constexpr int BM = 256, BK = 64, HALF = 128, HTB = HALF * BK * 2, STAGE_BYTES = 8 * HTB, NXCD = 8, WGM = 8;
__host__ __device__ __forceinline__ int lds_byte(int r, int c) { const int st = (r >> 4) * 2 + (c >> 5), rr = r & 15, cc = c & 31, ob = rr * 64 + cc * 2; return st * 1024 + (ob ^ (((ob >> 9) & 1) << 5)); }
__host__ __device__ __forceinline__ void stage_rc(int b, int& R, int& C) { const int st = b / 1024, sb = b % 1024, swz = sb ^ (((sb >> 9) & 1) << 5); R = (st >> 1) * 16 + swz / 64; C = (st & 1) * 32 + (swz % 64) / 2; }
__host__ __device__ __forceinline__ int perm32(int rho) { const int n = rho >> 4, i = rho & 15; return 8 * (i >> 2) + 4 * n + (i & 3); }
struct Unit { int pm, pn, kq, fin; };
struct Gemm { const bf16_t* A; const bf16_t* Bt; int M, N, K, lda, ldb; };
struct StaticOrder {
    int nM, nN, nwg, G, c;
    __device__ void init(int M_, int N_, int G_, int c_) { nM = M_ / BM; nN = N_ / BM; nwg = nM * nN; G = G_; c = c_; }
    __device__ bool next(int i, Unit& u) const {
        const long L = (long)i * G + c; if (L >= nwg) return false;
        int wgid = (int)L; { const int q = nwg / NXCD, r = nwg % NXCD, xcd = wgid % NXCD, off = wgid / NXCD; wgid = (xcd < r ? xcd * (q + 1) : r * (q + 1) + (xcd - r) * q) + off; }
        const int nig = WGM * nN, gid = wgid / nig, fm = gid * WGM, gsz = (nM - fm) < WGM ? (nM - fm) : WGM;
        u.pm = fm + ((wgid % nig) % gsz); u.pn = (wgid % nig) / gsz; u.kq = 0; u.fin = 1; return true;
    }
};
struct PairOrder {
    StaticOrder base; int khalf;
    __device__ bool next(int i, Unit& u) const { if (!base.next(i >> 1, u)) return false; u.kq = (i & 1) * khalf; u.fin = i & 1; return true; }
};
template <class Epi, class Sched>
__device__ __forceinline__ void gemm_phase(LAS unsigned char* lds, const Gemm g, const Sched& S, const Epi& E) {
    const int tid = threadIdx.x, wid = __builtin_amdgcn_readfirstlane(tid >> 6), lane = tid & 63, wr = wid >> 2, wc = wid & 3, fr = lane & 15, fq = lane >> 4;
    const int K = g.K, nt = K / BK;
    unsigned voffA[2], voffB[2];
#pragma unroll
    for (int i = 0; i < 2; ++i) { int R, C; stage_rc(tid * 16 + i * 8192, R, C); const int Rb = Epi::PERM ? ((R & ~31) + perm32(R & 31)) : R;
        voffA[i] = (unsigned)(R * g.lda + C) * 2u; voffB[i] = (unsigned)(Rb * g.ldb + C) * 2u; }
    const size_t kstep = (size_t)(BK * 2);
    const size_t hstepA = (size_t)HALF * g.lda * 2, tstepA = 2 * hstepA, hstepB = (size_t)HALF * g.ldb * 2, tstepB = 2 * hstepB;
    const unsigned ldsw = (unsigned)wid * 1024u;
    const int aoff = lds_byte(wr * 64 + fr, fq * 8), boff = lds_byte(wc * 32 + fr, fq * 8);
#define PG8_SA(b, h) (((b) * 2 + (h)) * HTB)
#define PG8_SB(b, h) ((4 + (b) * 2 + (h)) * HTB)
#define PG8_STAGE(bufoff, gbase, voff) do { _Pragma("unroll") for (int _i = 0; _i < 2; ++_i) \
        __builtin_amdgcn_global_load_lds((const unsigned*)((const char*)(gbase) + (voff)[_i]), (LAS unsigned*)(lds + (bufoff) + ldsw + _i * 8192), 16, 0, 0); } while (0)
#define PG8_LDA(dst, b, h) do { _Pragma("unroll") for (int m = 0; m < 4; ++m) _Pragma("unroll") for (int k = 0; k < 2; ++k) dst[m][k] = *(const LAS bf16x8*)(lds + PG8_SA(b, h) + aoff + m * 2048 + k * 1024); } while (0)
#define PG8_LDB(dst, b, h) do { _Pragma("unroll") for (int n = 0; n < 2; ++n) _Pragma("unroll") for (int k = 0; k < 2; ++k) dst[n][k] = *(const LAS bf16x8*)(lds + PG8_SB(b, h) + boff + n * 2048 + k * 1024); } while (0)
#define PG8_MMA(ai, bj, At, Bt) do { __builtin_amdgcn_s_setprio(1); _Pragma("unroll") for (int m = 0; m < 4; ++m) _Pragma("unroll") for (int n = 0; n < 2; ++n) _Pragma("unroll") for (int k = 0; k < 2; ++k) \
        acc[ai][bj][m][n] = __builtin_amdgcn_mfma_f32_16x16x32_bf16(Bt[n][k], At[m][k], acc[ai][bj][m][n], 0, 0, 0); __builtin_amdgcn_s_setprio(0); } while (0)
#define PG8_WAIT_V(n) asm volatile("s_waitcnt vmcnt(" #n ")" ::: "memory")
#define PG8_WAIT_L(n) asm volatile("s_waitcnt lgkmcnt(" #n ")" ::: "memory")
#define PG8_BAR __builtin_amdgcn_s_barrier()
#define PG8_SCHED __builtin_amdgcn_sched_barrier(0)
    Unit cur, nxt; int ui = 0;
    if (!S.next(0, cur)) return;
    f32x4 acc[2][2][4][2];
#pragma unroll
    for (int a = 0; a < 2; ++a)
#pragma unroll
        for (int b = 0; b < 2; ++b)
#pragma unroll
            for (int m = 0; m < 4; ++m)
#pragma unroll
                for (int n = 0; n < 2; ++n) acc[a][b][m][n] = (f32x4){0.f, 0.f, 0.f, 0.f};
    bf16x8 At[4][2], B0[2][2], B1[2][2];
    const char* cA = (const char*)g.A + (size_t)cur.pm * tstepA + (size_t)cur.kq * 2; const char* cB = (const char*)g.Bt + (size_t)cur.pn * tstepB + (size_t)cur.kq * 2;
    PG8_STAGE(PG8_SB(0, 0), cB, voffB); PG8_STAGE(PG8_SB(0, 1), cB + hstepB, voffB); PG8_STAGE(PG8_SA(0, 0), cA, voffA); PG8_STAGE(PG8_SA(0, 1), cA + hstepA, voffA);
    if (wr == 1) PG8_BAR;
    PG8_WAIT_V(2); PG8_BAR;
    PG8_STAGE(PG8_SB(1, 0), cB + kstep, voffB); PG8_STAGE(PG8_SA(1, 0), cA + kstep, voffA); PG8_STAGE(PG8_SB(1, 1), cB + hstepB + kstep, voffB);
    PG8_WAIT_V(6); PG8_BAR;
    for (;;) {
        const bool has_next = S.next(ui + 1, nxt);
        const char* nA = has_next ? (const char*)g.A + (size_t)nxt.pm * tstepA + (size_t)nxt.kq * 2 : cA; const char* nB = has_next ? (const char*)g.Bt + (size_t)nxt.pn * tstepB + (size_t)nxt.kq * 2 : cB;
        for (int t = 0; t < nt; t += 2) {
            const bool last = (t == nt - 2);
            const char* a1 = cA + (size_t)(t + 1) * kstep;
            const char* a2 = last ? nA : cA + (size_t)(t + 2) * kstep; const char* b2 = last ? nB : cB + (size_t)(t + 2) * kstep;
            const char* a3 = a2 + kstep; const char* b3 = b2 + kstep;
            PG8_LDB(B0, 0, 0); PG8_LDB(B1, 0, 1); PG8_SCHED; PG8_LDA(At, 0, 0); PG8_STAGE(PG8_SA(1, 1), a1 + hstepA, voffA);
            PG8_WAIT_V(8); PG8_WAIT_L(0); PG8_BAR; PG8_MMA(0, 0, At, B0); PG8_MMA(0, 1, At, B1); PG8_BAR; PG8_SCHED;
            PG8_LDA(At, 0, 1); PG8_STAGE(PG8_SB(0, 0), b2, voffB); PG8_STAGE(PG8_SB(0, 1), b2 + hstepB, voffB); PG8_STAGE(PG8_SA(0, 0), a2, voffA);
            PG8_WAIT_V(8); PG8_WAIT_L(0); PG8_BAR; PG8_MMA(1, 0, At, B0); PG8_MMA(1, 1, At, B1); PG8_BAR; PG8_SCHED;
            PG8_LDB(B0, 1, 0); PG8_LDB(B1, 1, 1); PG8_SCHED; PG8_LDA(At, 1, 0); PG8_STAGE(PG8_SA(0, 1), a2 + hstepA, voffA);
            PG8_WAIT_V(8); PG8_WAIT_L(0); PG8_BAR; PG8_MMA(0, 0, At, B0); PG8_MMA(0, 1, At, B1); PG8_BAR; PG8_SCHED;
            PG8_LDA(At, 1, 1); PG8_STAGE(PG8_SB(1, 0), b3, voffB); PG8_STAGE(PG8_SB(1, 1), b3 + hstepB, voffB); PG8_STAGE(PG8_SA(1, 0), a3, voffA);
            PG8_WAIT_V(8); PG8_WAIT_L(0); PG8_BAR; PG8_MMA(1, 0, At, B0); PG8_MMA(1, 1, At, B1); PG8_BAR; PG8_SCHED;
        }
        if (wr == 0) PG8_BAR;
        const bool keep = Epi::MID && !cur.fin;
        if (keep) E.mid(acc, cur, wr, wc, fr, fq); else E(acc, cur, wr, wc, fr, fq);
        if (!has_next) break;
        if (!keep)
#pragma unroll
        for (int a = 0; a < 2; ++a)
#pragma unroll
            for (int b = 0; b < 2; ++b)
#pragma unroll
                for (int m = 0; m < 4; ++m)
#pragma unroll
                    for (int n = 0; n < 2; ++n) acc[a][b][m][n] = (f32x4){0.f, 0.f, 0.f, 0.f};
        cur = nxt; cA = nA; cB = nB; ++ui;
        if (wr == 1) PG8_BAR;
    }
    PG8_WAIT_V(0);
    PG8_BAR;
#undef PG8_SA
#undef PG8_SB
#undef PG8_STAGE
#undef PG8_LDA
#undef PG8_LDB
#undef PG8_MMA
#undef PG8_WAIT_V
#undef PG8_WAIT_L
#undef PG8_BAR
#undef PG8_SCHED
}
}
using pg8::Unit;

struct EpiZ {
    static constexpr bool PERM = true, MID = false;
    bf16_t* Z; const float* rope; const float* gq; const float* gk;
    __device__ __forceinline__ void mid(f32x4 (&)[2][2][4][2], const Unit&, int, int, int, int) const {}
    __device__ __forceinline__ void operator()(const f32x4 (&acc)[2][2][4][2], const Unit& u, int wr, int wc, int fr, int fq) const {
        const int T = u.pn; const int row0 = u.pm * 256 + wr * 64 + fr; const int colp = wc * 32 + 8 * fq;
        if (T < 2) {
            const int i4 = 4 * (wc & 1) + fq;
            float lg[2];
#pragma unroll
            for (int bj = 0; bj < 2; ++bj) { const int head = 2 * bj + (wc >> 1); lg[bj] = log2f(1.f - exp2f(-5.f - (float)head)); }
#pragma unroll
            for (int ai = 0; ai < 2; ++ai)
#pragma unroll
                for (int m = 0; m < 4; ++m) {
                    const int row = row0 + ai * 128 + m * 16; const int t = row & (SEQ - 1); const float il = (float)(row & 127);
                    const f32x4* rp = (const f32x4*)(rope + ((size_t)t * 32 + 4 * i4) * 2); const f32x4 c0 = rp[0], c1 = rp[1];
                    const float cs[4] = {c0[0], c0[2], c1[0], c1[2]}, sn[4] = {c0[1], c0[3], c1[1], c1[3]};
#pragma unroll
                    for (int bj = 0; bj < 2; ++bj) {
                        const f32x4 x1 = acc[ai][bj][m][0], x2 = acc[ai][bj][m][1];
                        const float sc = (T == 0) ? exp2f(il * lg[bj]) : 0.125f * exp2f(-il * lg[bj]);
                        float y1[4], y2[4];
#pragma unroll
                        for (int k = 0; k < 4; ++k) { y1[k] = (x1[k] * cs[k] - x2[k] * sn[k]) * sc; y2[k] = (x1[k] * sn[k] + x2[k] * cs[k]) * sc; }
                        u32x4 w; w[0] = cvtpk(y1[0], y1[1]); w[1] = cvtpk(y1[2], y1[3]); w[2] = cvtpk(y2[0], y2[1]); w[3] = cvtpk(y2[2], y2[3]);
                        *(u32x4*)(Z + (size_t)row * ZP + 256 * T + 128 * bj + colp) = w;
                    }
                }
        } else if (T >= 6 && T < 10) {
            const bool isq = T < 8; const float* g = isq ? gq : gk; const float sc = isq ? C2 : 1.f;
            f32x4 gv[2][2];
#pragma unroll
            for (int bj = 0; bj < 2; ++bj)
#pragma unroll
                for (int n = 0; n < 2; ++n) gv[bj][n] = *(const f32x4*)(g + 32 * bj + 8 * fq + 4 * n);
#pragma unroll
            for (int ai = 0; ai < 2; ++ai)
#pragma unroll
                for (int m = 0; m < 4; ++m) {
                    const int row = row0 + ai * 128 + m * 16; float ss = 0.f;
#pragma unroll
                    for (int bj = 0; bj < 2; ++bj)
#pragma unroll
                        for (int n = 0; n < 2; ++n) { const f32x4 v = acc[ai][bj][m][n]; ss += (v[0] * v[0] + v[1] * v[1]) + (v[2] * v[2] + v[3] * v[3]); }
                    ss += __shfl_xor(ss, 16); ss += __shfl_xor(ss, 32);
                    const float rs = rsqrtf(ss * (1.f / 64.f) + EPS) * sc;
#pragma unroll
                    for (int bj = 0; bj < 2; ++bj) {
                        const f32x4 v0 = acc[ai][bj][m][0] * rs * gv[bj][0], v1 = acc[ai][bj][m][1] * rs * gv[bj][1];
                        u32x4 w; w[0] = cvtpk(v0[0], v0[1]); w[1] = cvtpk(v0[2], v0[3]); w[2] = cvtpk(v1[0], v1[1]); w[3] = cvtpk(v1[2], v1[3]);
                        *(u32x4*)(Z + (size_t)row * ZP + 256 * T + 64 * wc + 32 * bj + 8 * fq) = w;
                    }
                }
        } else {
            const int mode = (T == 4 || T == 5) ? 1 : (T >= 12 ? 2 : 0);
#pragma unroll
            for (int ai = 0; ai < 2; ++ai)
#pragma unroll
                for (int m = 0; m < 4; ++m) {
                    const int row = row0 + ai * 128 + m * 16;
#pragma unroll
                    for (int bj = 0; bj < 2; ++bj) {
                        f32x4 v0 = acc[ai][bj][m][0], v1 = acc[ai][bj][m][1];
                        if (mode) {
#pragma unroll
                            for (int k = 0; k < 4; ++k) { const float s0 = sigmoidf_(v0[k]), s1 = sigmoidf_(v1[k]); v0[k] = (mode == 1) ? v0[k] * s0 : s0; v1[k] = (mode == 1) ? v1[k] * s1 : s1; }
                        }
                        u32x4 w; w[0] = cvtpk(v0[0], v0[1]); w[1] = cvtpk(v0[2], v0[3]); w[2] = cvtpk(v1[0], v1[1]); w[3] = cvtpk(v1[2], v1[3]);
                        *(u32x4*)(Z + (size_t)row * ZP + 256 * T + 128 * bj + colp) = w;
                    }
                }
        }
    }
};
struct EpiMerge {
    static constexpr bool PERM = true, MID = true;
    const bf16_t* Z; bf16_t* MG;
    __device__ __forceinline__ void mid(f32x4 (&acc)[2][2][4][2], const Unit& u, int wr, int wc, int fr, int fq) const {
        const int row0 = u.pm * 256 + wr * 64 + fr; const int col0 = u.pn * 256 + wc * 32 + 8 * fq;
#pragma unroll
        for (int ai = 0; ai < 2; ++ai)
#pragma unroll
            for (int m = 0; m < 4; ++m)
#pragma unroll
                for (int bj = 0; bj < 2; ++bj) {
                    const bf16_t* zp = Z + (size_t)(row0 + ai * 128 + m * 16) * ZP + col0 + 128 * bj;
                    const u32x4 a = *(const u32x4*)(zp + AR_OFF), f = *(const u32x4*)(zp + AF_OFF);
#pragma unroll
                    for (int k = 0; k < 2; ++k) {
                        acc[ai][bj][m][0][2 * k] *= bflo(a[k]) / bflo(f[k]); acc[ai][bj][m][0][2 * k + 1] *= bfhi(a[k]) / bfhi(f[k]);
                        acc[ai][bj][m][1][2 * k] *= bflo(a[2 + k]) / bflo(f[2 + k]); acc[ai][bj][m][1][2 * k + 1] *= bfhi(a[2 + k]) / bfhi(f[2 + k]);
                    }
                    asm volatile("" : "+v"(acc[ai][bj][m][0]), "+v"(acc[ai][bj][m][1]) :: "memory");
                }
    }
    __device__ __forceinline__ void operator()(const f32x4 (&acc)[2][2][4][2], const Unit& u, int wr, int wc, int fr, int fq) const {
        const int row0 = u.pm * 256 + wr * 64 + fr; const int col0 = u.pn * 256 + wc * 32 + 8 * fq;
#pragma unroll
        for (int ai = 0; ai < 2; ++ai)
#pragma unroll
            for (int m = 0; m < 4; ++m)
#pragma unroll
                for (int bj = 0; bj < 2; ++bj) {
                    const int row = row0 + ai * 128 + m * 16;
                    const u32x4 f = *(const u32x4*)(Z + (size_t)row * ZP + col0 + 128 * bj + AF_OFF);
                    const f32x4 v0 = acc[ai][bj][m][0], v1 = acc[ai][bj][m][1];
                    u32x4 w; w[0] = cvtpk(v0[0] * bflo(f[0]), v0[1] * bfhi(f[0])); w[1] = cvtpk(v0[2] * bflo(f[1]), v0[3] * bfhi(f[1]));
                    w[2] = cvtpk(v1[0] * bflo(f[2]), v1[1] * bfhi(f[2])); w[3] = cvtpk(v1[2] * bflo(f[3]), v1[3] * bfhi(f[3]));
                    *(u32x4*)(MG + (size_t)row * DM + col0 + 128 * bj) = w;
                }
    }
};
struct EpiOut {
    static constexpr bool PERM = false, MID = false;
    const float* x; float* out; bf16_t* X1B; float* SSQ;
    __device__ __forceinline__ void mid(f32x4 (&)[2][2][4][2], const Unit&, int, int, int, int) const {}
    __device__ __forceinline__ void operator()(const f32x4 (&acc)[2][2][4][2], const Unit& u, int wr, int wc, int fr, int fq) const {
        const int row0 = u.pm * 256 + wr * 64 + fr; const int col0 = u.pn * 256 + wc * 32 + 4 * fq;
#pragma unroll
        for (int ai = 0; ai < 2; ++ai)
#pragma unroll
            for (int m = 0; m < 4; ++m) {
                const int row = row0 + ai * 128 + m * 16; const size_t off = (size_t)row * DM + col0; float ss = 0.f;
#pragma unroll
                for (int bj = 0; bj < 2; ++bj)
#pragma unroll
                    for (int n = 0; n < 2; ++n) {
                        const f32x4 v = *(const f32x4*)(x + off + bj * 128 + n * 16) + acc[ai][bj][m][n];
                        *(f32x4*)(out + off + bj * 128 + n * 16) = v;
                        u32x2 w; w[0] = cvtpk(v[0], v[1]); w[1] = cvtpk(v[2], v[3]); *(u32x2*)(X1B + off + bj * 128 + n * 16) = w;
                        ss += (v[0] * v[0] + v[1] * v[1]) + (v[2] * v[2] + v[3] * v[3]);
                    }
                ss += __shfl_xor(ss, 16); ss += __shfl_xor(ss, 32);
                if (fq == 0) SSQ[(size_t)row * 16 + u.pn * 4 + wc] = ss;
            }
    }
};
struct EpiGU {
    static constexpr bool PERM = true, MID = false;
    const float* SSQ; bf16_t* HID;
    __device__ __forceinline__ void mid(f32x4 (&)[2][2][4][2], const Unit&, int, int, int, int) const {}
    __device__ __forceinline__ void operator()(const f32x4 (&acc)[2][2][4][2], const Unit& u, int wr, int wc, int fr, int fq) const {
        const int row0 = u.pm * 256 + wr * 64 + fr; const int col0 = u.pn * 128 + wc * 32 + 8 * fq;
#pragma unroll
        for (int ai = 0; ai < 2; ++ai)
#pragma unroll
            for (int m = 0; m < 4; ++m) {
                const int row = row0 + ai * 128 + m * 16;
                const f32x4* sp = (const f32x4*)(SSQ + (size_t)row * 16); const f32x4 s0 = sp[0], s1 = sp[1], s2 = sp[2], s3 = sp[3];
                const float ss = (((s0[0] + s0[1]) + (s0[2] + s0[3])) + ((s1[0] + s1[1]) + (s1[2] + s1[3]))) + (((s2[0] + s2[1]) + (s2[2] + s2[3])) + ((s3[0] + s3[1]) + (s3[2] + s3[3])));
                const float rs = rsqrtf(ss * (1.f / 1024.f) + EPS);
                float hv[8];
#pragma unroll
                for (int n = 0; n < 2; ++n)
#pragma unroll
                    for (int k = 0; k < 4; ++k) { const float gte = acc[ai][0][m][n][k] * rs, up = acc[ai][1][m][n][k] * rs; hv[4 * n + k] = gte * sigmoidf_(gte) * up; }
                u32x4 w; w[0] = cvtpk(hv[0], hv[1]); w[1] = cvtpk(hv[2], hv[3]); w[2] = cvtpk(hv[4], hv[5]); w[3] = cvtpk(hv[6], hv[7]);
                *(u32x4*)(HID + (size_t)row * DFF + col0) = w;
            }
    }
};
struct EpiDown {
    static constexpr bool PERM = false, MID = false;
    float* out;
    __device__ __forceinline__ void mid(f32x4 (&)[2][2][4][2], const Unit&, int, int, int, int) const {}
    __device__ __forceinline__ void operator()(const f32x4 (&acc)[2][2][4][2], const Unit& u, int wr, int wc, int fr, int fq) const {
        const int row0 = u.pm * 256 + wr * 64 + fr; const int col0 = u.pn * 256 + wc * 32 + 4 * fq;
#pragma unroll
        for (int ai = 0; ai < 2; ++ai)
#pragma unroll
            for (int m = 0; m < 4; ++m) {
                const size_t off = (size_t)(row0 + ai * 128 + m * 16) * DM + col0;
#pragma unroll
                for (int bj = 0; bj < 2; ++bj)
#pragma unroll
                    for (int n = 0; n < 2; ++n) { float* p = out + off + bj * 128 + n * 16; *(f32x4*)p = *(const f32x4*)p + acc[ai][bj][m][n]; }
            }
    }
};

struct Params {
    const float *x, *g_mix, *w_in, *b_forget, *g_ret_norm, *w_ret_o, *g_fox_q, *g_fox_k, *w_fox_o, *w_out, *g_ffn, *w_gate, *w_up, *w_down;
    float* out; unsigned char* ws; int ph_lo, ph_hi;
};

__device__ __forceinline__ int win_src(int np) {
    const int T = np >> 8, p = np & 255;
    if (T < 2) { const int head = p >> 6, w = p & 63, i = w >> 3, j = w & 7; const int d = (j < 4) ? (4 * i + j) : (32 + 4 * i + (j - 4)); return T * 256 + head * 64 + d; }
    if (T >= 6 && T < 10) { const int hit = (p & 127) >> 5, d = 32 * (p >> 7) + (p & 31); return 256 * T + hit * 64 + d; }
    if (T >= 12) return np + 8;
    return np;
}
__device__ __forceinline__ void transpose_tile(LAS float* scr, const float* W, int pitch, int srccol, const float* kscale, bf16_t* WT, int ldt, int n0, int k0, int koff) {
    const int tid = threadIdx.x;
    { const int nn = tid & 63, kk0 = tid >> 6;
#pragma unroll
      for (int ps = 0; ps < 8; ++ps) { const int kk = kk0 + 8 * ps; scr[kk * 65 + nn] = W[(size_t)(k0 + kk) * pitch + srccol]; } }
    __syncthreads();
    { const int nn = tid >> 3, c = tid & 7; float v[8];
#pragma unroll
      for (int j = 0; j < 8; ++j) { v[j] = scr[(8 * c + j) * 65 + nn]; if (kscale) v[j] *= kscale[k0 + 8 * c + j]; }
      u32x4 o; o[0] = cvtpk(v[0], v[1]); o[1] = cvtpk(v[2], v[3]); o[2] = cvtpk(v[4], v[5]); o[3] = cvtpk(v[6], v[7]);
      *(u32x4*)(WT + (size_t)(n0 + nn) * ldt + koff + k0 + 8 * c) = o; }
    __syncthreads();
}
__device__ __forceinline__ void p0_prologue(const Params& P, LAS unsigned char* lds) {
    const int tid = threadIdx.x, lane = tid & 63, wave = tid >> 6, G = gridDim.x;
    unsigned char* ws = P.ws;
    bf16_t* WIN = (bf16_t*)(ws + WS_WIN); bf16_t* WCAT = (bf16_t*)(ws + WS_WCAT); bf16_t* WOUT = (bf16_t*)(ws + WS_WOUT); bf16_t* WGU = (bf16_t*)(ws + WS_WGU); bf16_t* WDN = (bf16_t*)(ws + WS_WDN);
    LAS float* scr = (LAS float*)lds;
    constexpr int T0 = 80 * 16, T1 = 16 * 8, T2 = 16 * 8, T3 = 16 * 16, T4 = 88 * 16, T5 = 16 * 44;
    constexpr int NT = T0 + T1 + T2 + T3 + T4 + T5;
    for (int it = blockIdx.x; it < NT; it += G) {
        int r = it; const int nn = tid & 63;
        if (r < T0) { const int tn = r / 16, tk = r % 16; transpose_tile(scr, P.w_in, INC, win_src(tn * 64 + nn), nullptr, WIN, 1024, tn * 64, tk * 64, 0); continue; } r -= T0;
        if (r < T1) { const int tn = r / 8, tk = r % 8; transpose_tile(scr, P.w_ret_o, 1024, tn * 64 + nn, nullptr, WCAT, 1024, tn * 64, tk * 64, 0); continue; } r -= T1;
        if (r < T2) { const int tn = r / 8, tk = r % 8; transpose_tile(scr, P.w_fox_o, 1024, tn * 64 + nn, nullptr, WCAT, 1024, tn * 64, tk * 64, 512); continue; } r -= T2;
        if (r < T3) { const int tn = r / 16, tk = r % 16; transpose_tile(scr, P.w_out, 1024, tn * 64 + nn, nullptr, WOUT, 1024, tn * 64, tk * 64, 0); continue; } r -= T3;
        if (r < T4) { const int tn = r / 16, tk = r % 16; const int n0 = tn * 64, T = n0 >> 8, p = n0 & 255; const float* W = (p >= 128) ? P.w_up : P.w_gate;
                      transpose_tile(scr, W, DFF, 128 * T + (p & 127) + nn, P.g_ffn, WGU, 1024, n0, tk * 64, 0); continue; } r -= T4;
        { const int tn = r / 44, tk = r % 44; transpose_tile(scr, P.w_down, 1024, tn * 64 + nn, nullptr, WDN, DFF, tn * 64, tk * 64, 0); }
    }
    { float* rope = (float*)(ws + WS_ROPE);
      for (int i = blockIdx.x * 512 + tid; i < SEQ * 32; i += G * 512) {
          const int t = i >> 5, d = i & 31;
          const float inv_freq = 1.0f / exp2f((float)d * (13.287712379549449f / 32.f));
          const float ang = (float)t * inv_freq;
          const double ad = (double)ang; const double nrev = __builtin_rint(ad * 0.15915494309189535); const float rr = (float)(ad - nrev * 6.283185307179586);
          rope[2 * i] = cosf(rr); rope[2 * i + 1] = sinf(rr);
      } }
    LAS float* wf = (LAS float*)(lds + 32768);
    for (int i = tid; i < 8192; i += 512) wf[i] = P.w_in[(size_t)(i >> 3) * INC + 3072 + (i & 7)];
    __syncthreads();
    bf16_t* XN = (bf16_t*)(ws + WS_A); float* LOGF = (float*)(ws + WS_LOGF);
    const int gw = blockIdx.x * 8 + wave, NGW = G * 8;
    for (int m = gw; m < M; m += NGW) {
        const f32x4* xr = (const f32x4*)(P.x + (size_t)m * DM) + lane; f32x4 v[4]; float ss = 0.f;
#pragma unroll
        for (int j = 0; j < 4; ++j) { v[j] = xr[64 * j]; ss += (v[j][0] * v[j][0] + v[j][1] * v[j][1]) + (v[j][2] * v[j][2] + v[j][3] * v[j][3]); }
        const float rstd = rsqrtf(wave_sum(ss) * (1.f / DM) + EPS);
        float fa[8];
#pragma unroll
        for (int q = 0; q < 8; ++q) fa[q] = 0.f;
#pragma unroll
        for (int j = 0; j < 4; ++j) {
            const f32x4 gm = ((const f32x4*)P.g_mix)[lane + 64 * j]; v[j] = v[j] * rstd * gm;
            u32x2 w; w[0] = cvtpk(v[j][0], v[j][1]); w[1] = cvtpk(v[j][2], v[j][3]);
            *(u32x2*)(XN + (size_t)m * DM + 4 * lane + 256 * j) = w;
#pragma unroll
            for (int k = 0; k < 4; ++k) { const int col = 4 * lane + 256 * j + k; const f32x4 w0 = *(const LAS f32x4*)(wf + col * 8), w1 = *(const LAS f32x4*)(wf + col * 8 + 4);
#pragma unroll
                for (int q = 0; q < 4; ++q) { fa[q] += v[j][k] * w0[q]; fa[4 + q] += v[j][k] * w1[q]; } }
        }
#pragma unroll
        for (int q = 0; q < 8; ++q) fa[q] = wave_sum(fa[q]);
        float z = fa[0];
#pragma unroll
        for (int q = 1; q < 8; ++q) z = (lane == q) ? fa[q] : z;
        if (lane < 8) { z += P.b_forget[lane]; const float ls = fminf(z, 0.f) - log1pf(expf(-fabsf(z))); LOGF[(size_t)m * 8 + lane] = ls * LOG2E; }
    }
}

__device__ __forceinline__ void cumsum_c2(const Params& P) {
    const int lane = threadIdx.x & 63, gw = blockIdx.x * 8 + (threadIdx.x >> 6);
    const float* LOGF = (const float*)(P.ws + WS_LOGF); float* Cc = (float*)(P.ws + WS_C2);
    for (int bh = gw; bh < 64; bh += gridDim.x * 8) {
        const int b = bh >> 3, h = bh & 7; const float* src = LOGF + ((size_t)b * SEQ + 128 * lane) * 8 + h;
        float s = 0.f;
        for (int i = 0; i < 128; ++i) s += src[i * 8];
        float inc = s;
#pragma unroll
        for (int o = 1; o < 64; o <<= 1) { const float v = __shfl_up(inc, o); if (lane >= o) inc += v; }
        float run = inc - s; float* dst = Cc + (size_t)bh * SEQ + 128 * lane;
        for (int i = 0; i < 128; ++i) { run += src[i * 8]; dst[i] = run; }
    }
}

constexpr int KS = 144, VS = 272;
__device__ __forceinline__ void ret_kv_phase(const Params& P, LAS unsigned char* lds) {
    const int tid = threadIdx.x, lane = tid & 63, w = __builtin_amdgcn_readfirstlane(tid >> 6), r = lane & 31, h = lane >> 5;
    const int q4 = (lane & 15) >> 2, p4 = lane & 3, g16 = (lane >> 4) & 1;
    const bf16_t* Z = (const bf16_t*)(P.ws + WS_Z); float* KV = (float*)(P.ws + WS_A);
    constexpr int HB = 128 * KS + 128 * VS;
    for (int u = blockIdx.x; u < 1024; u += gridDim.x) {
        const int b = u >> 7, n = (u >> 1) & 63, hp = u & 1; const size_t R0 = (size_t)b * SEQ + (size_t)n * 128;
#pragma unroll
        for (int i = 0; i < 4; ++i) { const int id = tid + 512 * i; const int hh = id >> 10, row = (id >> 3) & 127, ch = id & 7;
            const u32x4 v = *(const u32x4*)(Z + (R0 + row) * ZP + KR_OFF + (2 * hp + hh) * 64 + 8 * ch);
            *(LAS u32x4*)(lds + hh * HB + row * KS + ch * 16) = v; }
#pragma unroll
        for (int i = 0; i < 8; ++i) { const int id = tid + 512 * i; const int hh = id >> 11, row = (id >> 4) & 127, ch = id & 15;
            const u32x4 v = *(const u32x4*)(Z + (R0 + row) * ZP + VR_OFF + (2 * hp + hh) * 128 + 8 * ch);
            *(LAS u32x4*)(lds + hh * HB + 128 * KS + row * VS + ch * 16) = v; }
        __syncthreads();
        const int hh = w >> 2, eb = w & 3, head = 2 * hp + hh;
        const LAS unsigned char* Kt = lds + hh * HB; const LAS unsigned char* Vt = Kt + 128 * KS;
        f32x16 acc[2];
#pragma unroll
        for (int i = 0; i < 16; ++i) { acc[0][i] = 0.f; acc[1][i] = 0.f; }
#pragma unroll
        for (int ks = 0; ks < 8; ++ks) {
            const int jr = 16 * ks + 8 * h + q4;
            const bf16x8 bfv = cat8(vtr(Vt + jr * VS + (32 * eb + 16 * g16 + 4 * p4) * 2), vtr(Vt + (jr + 4) * VS + (32 * eb + 16 * g16 + 4 * p4) * 2));
#pragma unroll
            for (int db = 0; db < 2; ++db) {
                const bf16x8 af = cat8(vtr(Kt + jr * KS + (32 * db + 16 * g16 + 4 * p4) * 2), vtr(Kt + (jr + 4) * KS + (32 * db + 16 * g16 + 4 * p4) * 2));
                acc[db] = MFMA32(af, bfv, acc[db]);
            }
        }
        float* dst = KV + ((size_t)((b * 64 + n) * 4 + head)) * 8192 + 32 * eb + r;
#pragma unroll
        for (int db = 0; db < 2; ++db)
#pragma unroll
            for (int i = 0; i < 16; ++i) dst[(32 * db + crow(i, h)) * 128] = acc[db][i];
        __syncthreads();
    }
}
__device__ __forceinline__ void ret_scan(const Params& P) {
    const float* KV = (const float*)(P.ws + WS_A); bf16_t* ST = (bf16_t*)(P.ws + WS_A + 64 * MiB);
    for (int p = blockIdx.x * 512 + threadIdx.x; p < 131072; p += gridDim.x * 512) {
        const int b = p >> 14, head = (p >> 12) & 3, de = p & 4095;
        const float g = exp2f(128.f * log2f(1.f - exp2f(-5.f - (float)head)));
        float s0 = 0.f, s1 = 0.f;
#pragma unroll 8
        for (int n = 0; n < 64; ++n) {
            const size_t off = ((size_t)((b * 64 + n) * 4 + head)) * 8192 + 2 * de;
            *(unsigned*)(ST + off) = cvtpk(s0, s1);
            const f32x2 kv = *(const f32x2*)(KV + off);
            s0 = g * (s0 + kv[0]); s1 = g * (s1 + kv[1]);
        }
    }
}
constexpr int FOX_BUF = 64 * KS * 2 + 256;
constexpr int FOX_SCR = 2 * FOX_BUF;
__device__ __forceinline__ void fox_phase(const Params& P, LAS unsigned char* lds) {
    const int tid = threadIdx.x, lane = tid & 63, w = __builtin_amdgcn_readfirstlane(tid >> 6), r = lane & 31, h = lane >> 5;
    const bf16_t* Z = (const bf16_t*)(P.ws + WS_Z); const float* Cc = (const float*)(P.ws + WS_C2); bf16_t* OM = (bf16_t*)(P.ws + WS_B);
    float mq = fabsf(P.g_fox_q[lane]), mk = fabsf(P.g_fox_k[lane]);
#pragma unroll
    for (int o = 1; o < 64; o <<= 1) { mq = fmaxf(mq, __shfl_xor(mq, o)); mk = fmaxf(mk, __shfl_xor(mk, o)); }
    const float smax2 = 8.f * mq * mk * LOG2E * 1.02f + 0.25f;
    const float thr = -150.f - 2.f * smax2;
    LAS float* ascr = (LAS float*)(lds + FOX_SCR) + w * 32;
    const int srow = tid >> 3, sch = tid & 7; const int soff = srow * KS + sch * 16;
    const int q4 = (lane & 15) >> 2, p4 = lane & 3, g16 = (lane >> 4) & 1;
    for (int u = blockIdx.x; u < 2048; u += gridDim.x) {
        const int bh = u >> 5, qb = u & 31, b = bh >> 3, hd = bh & 7; const size_t rowbase = (size_t)b * SEQ; const int q0 = qb * 256;
        const float* c2 = Cc + (size_t)bh * SEQ;
        const int nt_all = 4 * qb + 4; const float cq0 = c2[q0];
        int t0;
        { const int t1 = lane, t2 = lane + 64;
          const bool e1 = (t1 < 4 * qb) && (cq0 - c2[64 * t1 + 63] <= thr);
          const bool e2 = (t2 < 4 * qb) && (cq0 - c2[64 * t2 + 63] <= thr);
          t0 = __popcll(__ballot(e1)) + __popcll(__ballot(e2)); }
        t0 = __builtin_amdgcn_readfirstlane(t0);
        const bf16_t* qp = Z + (rowbase + q0 + 32 * w + r) * ZP + QF_OFF + hd * 64 + 8 * h;
        bf16x8 qr[4];
#pragma unroll
        for (int s = 0; s < 4; ++s) qr[s] = *(const bf16x8*)(qp + 16 * s);
        const float cq2 = c2[q0 + 32 * w + r];
        const bf16_t* kg = Z + (rowbase + srow) * ZP + KF_OFF + hd * 64 + 8 * sch;
        u32x4 kreg = *(const u32x4*)(kg + (size_t)t0 * 64 * ZP), vreg = *(const u32x4*)(kg + (size_t)t0 * 64 * ZP + (VF_OFF - KF_OFF));
        float creg = (tid < 64) ? c2[64 * t0 + tid] : 0.f;
        *(LAS u32x4*)(lds + soff) = kreg; *(LAS u32x4*)(lds + 64 * KS + soff) = vreg; if (tid < 64) *(LAS float*)(lds + 128 * KS + 4 * tid) = creg;
        __syncthreads();
        f32x16 o0, o1;
#pragma unroll
        for (int i = 0; i < 16; ++i) { o0[i] = 0.f; o1[i] = 0.f; }
        float m_run = -INFINITY, l_run = 0.f;
        for (int t = t0; t < nt_all; ++t) {
            const int bi = (t - t0) & 1; const bool has_next = t + 1 < nt_all;
            if (has_next) { kreg = *(const u32x4*)(kg + (size_t)(t + 1) * 64 * ZP); vreg = *(const u32x4*)(kg + (size_t)(t + 1) * 64 * ZP + (VF_OFF - KF_OFF)); if (tid < 64) creg = c2[64 * (t + 1) + tid]; }
            const LAS unsigned char* Kb = lds + bi * FOX_BUF; const LAS unsigned char* Vb = Kb + 64 * KS; const LAS float* ckb = (const LAS float*)(Kb + 128 * KS);
            if (64 * t <= q0 + 32 * w + 31) {
                f32x16 p0, p1;
#pragma unroll
                for (int g = 0; g < 4; ++g) { const f32x4 ca = *(const LAS f32x4*)(ckb + 8 * g + 4 * h), cb = *(const LAS f32x4*)(ckb + 32 + 8 * g + 4 * h);
#pragma unroll
                    for (int j = 0; j < 4; ++j) { p0[4 * g + j] = cq2 - ca[j]; p1[4 * g + j] = cq2 - cb[j]; } }
                const LAS unsigned char* kb = Kb + r * KS + h * 16;
#pragma unroll
                for (int s = 0; s < 4; ++s) { const bf16x8 k0 = *(const LAS bf16x8*)(kb + s * 32), k1 = *(const LAS bf16x8*)(kb + 32 * KS + s * 32);
                    p0 = MFMA32(k0, qr[s], p0); p1 = MFMA32(k1, qr[s], p1); }
                if (t >= 4 * qb) { const int qrel = 32 * w + r, kb0 = 64 * (t - 4 * qb) + 4 * h;
#pragma unroll
                    for (int i = 0; i < 16; ++i) { const int kv = kb0 + (i & 3) + 8 * (i >> 2); if (kv > qrel) p0[i] = -INFINITY; if (kv + 32 > qrel) p1[i] = -INFINITY; } }
                float mt = fmaxf(p0[0], p1[0]);
#pragma unroll
                for (int i = 1; i < 16; ++i) mt = fmaxf(mt, fmaxf(p0[i], p1[i]));
                mt = fmaxf(mt, __shfl_xor(mt, 32));
                const float mn = fmaxf(m_run, mt); const float alpha = __builtin_amdgcn_exp2f(m_run - mn); m_run = mn;
                float ps = 0.f;
#pragma unroll
                for (int i = 0; i < 16; ++i) { p0[i] = __builtin_amdgcn_exp2f(p0[i] - mn); p1[i] = __builtin_amdgcn_exp2f(p1[i] - mn); ps += p0[i] + p1[i]; }
                l_run = l_run * alpha + ps;
                if (h == 0) ascr[r] = alpha;
#pragma unroll
                for (int i = 0; i < 16; ++i) { const float a = ascr[crow(i, h)]; o0[i] *= a; o1[i] *= a; }
                bf16x8 pf[4]; pf[0] = pack8(p0, 0); pf[1] = pack8(p0, 8); pf[2] = pack8(p1, 0); pf[3] = pack8(p1, 8);
                const LAS unsigned char* vb = Vb + (4 * h + q4) * KS + g16 * 32 + p4 * 8;
#pragma unroll
                for (int ks = 0; ks < 4; ++ks) {
                    const bf16x8 v0 = cat8(vtr(vb + (16 * ks) * KS), vtr(vb + (16 * ks + 8) * KS));
                    const bf16x8 v1 = cat8(vtr(vb + (16 * ks) * KS + 64), vtr(vb + (16 * ks + 8) * KS + 64));
                    o0 = MFMA32(pf[ks], v0, o0); o1 = MFMA32(pf[ks], v1, o1);
                }
            }
            if (has_next) { LAS unsigned char* nb = lds + (bi ^ 1) * FOX_BUF; *(LAS u32x4*)(nb + soff) = kreg; *(LAS u32x4*)(nb + 64 * KS + soff) = vreg; if (tid < 64) *(LAS float*)(nb + 128 * KS + 4 * tid) = creg; }
            __syncthreads();
        }
        const float lt = l_run + __shfl_xor(l_run, 32);
        if (h == 0) ascr[r] = 1.f / lt;
        bf16_t* op = OM + (rowbase + q0 + 32 * w) * DM + 512 + hd * 64 + r;
#pragma unroll
        for (int i = 0; i < 16; ++i) { const float a = ascr[crow(i, h)]; const int row = crow(i, h);
            op[(size_t)row * DM] = (bf16_t)(cvtpk(o0[i] * a, 0.f) & 0xffffu); op[(size_t)row * DM + 32] = (bf16_t)(cvtpk(o1[i] * a, 0.f) & 0xffffu); }
    }
    __syncthreads();
}
__device__ __forceinline__ void ret_out_phase(const Params& P, LAS unsigned char* lds) {
    const int tid = threadIdx.x, lane = tid & 63, w = __builtin_amdgcn_readfirstlane(tid >> 6), r = lane & 31, h = lane >> 5;
    const int q4 = (lane & 15) >> 2, p4 = lane & 3, g16 = (lane >> 4) & 1;
    const bf16_t* Z = (const bf16_t*)(P.ws + WS_Z); const bf16_t* ST = (const bf16_t*)(P.ws + WS_A + 64 * MiB); bf16_t* OM = (bf16_t*)(P.ws + WS_B);
    constexpr int HB = 128 * KS + 128 * VS + 64 * VS;
    for (int u = blockIdx.x; u < 1024; u += gridDim.x) {
        const int b = u >> 7, n = (u >> 1) & 63, hp = u & 1; const size_t R0 = (size_t)b * SEQ + (size_t)n * 128;
#pragma unroll
        for (int i = 0; i < 4; ++i) { const int id = tid + 512 * i; const int hh = id >> 10, row = (id >> 3) & 127, ch = id & 7;
            const u32x4 v = *(const u32x4*)(Z + (R0 + row) * ZP + KR_OFF + (2 * hp + hh) * 64 + 8 * ch);
            *(LAS u32x4*)(lds + hh * HB + row * KS + ch * 16) = v; }
#pragma unroll
        for (int i = 0; i < 8; ++i) { const int id = tid + 512 * i; const int hh = id >> 11, row = (id >> 4) & 127, ch = id & 15;
            const u32x4 v = *(const u32x4*)(Z + (R0 + row) * ZP + VR_OFF + (2 * hp + hh) * 128 + 8 * ch);
            *(LAS u32x4*)(lds + hh * HB + 128 * KS + row * VS + ch * 16) = v; }
#pragma unroll
        for (int i = 0; i < 4; ++i) { const int id = tid + 512 * i; const int hh = id >> 10, row = (id >> 4) & 63, ch = id & 15;
            const u32x4 v = *(const u32x4*)(ST + ((size_t)((b * 64 + n) * 4 + 2 * hp + hh)) * 8192 + row * 128 + 8 * ch);
            *(LAS u32x4*)(lds + hh * HB + 128 * KS + 128 * VS + row * VS + ch * 16) = v; }
        const int hh = w >> 2, wq = w & 3, head = 2 * hp + hh;
        const bf16_t* qp = Z + (R0 + 32 * wq + r) * ZP + QR_OFF + head * 64 + 8 * h;
        bf16x8 qr[4];
#pragma unroll
        for (int s = 0; s < 4; ++s) qr[s] = *(const bf16x8*)(qp + 16 * s);
        __syncthreads();
        const LAS unsigned char* Kt = lds + hh * HB; const LAS unsigned char* Vt = Kt + 128 * KS; const LAS unsigned char* Sp = Vt + 128 * VS;
        f32x16 o[4];
#pragma unroll
        for (int e = 0; e < 4; ++e)
#pragma unroll
            for (int i = 0; i < 16; ++i) o[e][i] = 0.f;
        const int coff = (16 * g16 + 4 * p4) * 2;
        for (int jb = 0; jb <= wq; ++jb) {
            f32x16 p;
#pragma unroll
            for (int i = 0; i < 16; ++i) p[i] = 0.f;
            const LAS unsigned char* kb = Kt + (32 * jb + r) * KS + h * 16;
#pragma unroll
            for (int s = 0; s < 4; ++s) p = MFMA32(*(const LAS bf16x8*)(kb + s * 32), qr[s], p);
            if (jb == wq) {
#pragma unroll
                for (int i = 0; i < 16; ++i) if (crow(i, h) > r) p[i] = 0.f;
            }
            const bf16x8 pf0 = pack8(p, 0), pf1 = pack8(p, 8);
            const LAS unsigned char* vb = Vt + (32 * jb + 4 * h + q4) * VS + coff;
#pragma unroll
            for (int e = 0; e < 4; ++e) {
                const bf16x8 v0 = cat8(vtr(vb + e * 64), vtr(vb + 8 * VS + e * 64));
                const bf16x8 v1 = cat8(vtr(vb + 16 * VS + e * 64), vtr(vb + 24 * VS + e * 64));
                o[e] = MFMA32(pf0, v0, o[e]); o[e] = MFMA32(pf1, v1, o[e]);
            }
        }
        { const LAS unsigned char* sb = Sp + (8 * h + q4) * VS + coff;
#pragma unroll
          for (int s = 0; s < 4; ++s)
#pragma unroll
              for (int e = 0; e < 4; ++e) { const bf16x8 sf = cat8(vtr(sb + (16 * s) * VS + e * 64), vtr(sb + (16 * s + 4) * VS + e * 64)); o[e] = MFMA32(qr[s], sf, o[e]); } }
        float gn[4];
#pragma unroll
        for (int e = 0; e < 4; ++e) gn[e] = P.g_ret_norm[head * 128 + 32 * e + r];
#pragma unroll
        for (int i = 0; i < 16; ++i) {
            float s1 = (o[0][i] + o[1][i]) + (o[2][i] + o[3][i]);
            float s2 = (o[0][i] * o[0][i] + o[1][i] * o[1][i]) + (o[2][i] * o[2][i] + o[3][i] * o[3][i]);
#pragma unroll
            for (int x = 1; x < 32; x <<= 1) { s1 += __shfl_xor(s1, x); s2 += __shfl_xor(s2, x); }
            const float mu = s1 * (1.f / 128.f); const float var = fmaxf(s2 * (1.f / 128.f) - mu * mu, 0.f); const float rs = rsqrtf(var + EPS);
            const size_t row = R0 + 32 * wq + crow(i, h);
            const bf16_t* gp = Z + row * ZP + GR_OFF + head * 128 + r; bf16_t* op = OM + row * DM + head * 128 + r;
#pragma unroll
            for (int e = 0; e < 4; ++e) { const float gt = __uint_as_float((unsigned)gp[32 * e] << 16); op[32 * e] = (bf16_t)(cvtpk((o[e][i] - mu) * rs * gn[e] * gt, 0.f) & 0xffffu); }
        }
        __syncthreads();
    }
}

constexpr int NPHASE = 9;
__global__ void __launch_bounds__(512, 2) fwd_megakernel(Params P) {
    extern __shared__ __attribute__((aligned(16))) unsigned char lds_raw[];
    LAS unsigned char* lds = (LAS unsigned char*)lds_raw;
    cg::grid_group grid = cg::this_grid();
    unsigned char* ws = P.ws; const int lo = P.ph_lo, hi = P.ph_hi; const int G = gridDim.x;
#ifndef PH_MASK
#define PH_MASK 0x1ff
#endif
#define IN(k) (((PH_MASK >> (k)) & 1) && lo <= (k) && (k) < hi)
#define SEAM(k) do { if (IN(k) && IN((k) + 1)) grid.sync(); } while (0)
    if (IN(0)) { p0_prologue(P, lds); __syncthreads(); }
    SEAM(0);
    if (IN(1)) {
        cumsum_c2(P);
        pg8::Gemm g{(const bf16_t*)(ws + WS_A), (const bf16_t*)(ws + WS_WIN), M, ZP, DM, DM, DM}; pg8::StaticOrder S; S.init(M, ZP, G, (int)blockIdx.x);
        EpiZ E{(bf16_t*)(ws + WS_Z), (const float*)(ws + WS_ROPE), P.g_fox_q, P.g_fox_k};
        pg8::gemm_phase<EpiZ, pg8::StaticOrder>(lds, g, S, E);
    }
    SEAM(1);
    if (IN(2)) { ret_kv_phase(P, lds); }
    SEAM(2);
    if (IN(3)) { ret_scan(P); fox_phase(P, lds); }
    SEAM(3);
    if (IN(4)) { ret_out_phase(P, lds); }
    SEAM(4);
    if (IN(5)) {
        pg8::Gemm g{(const bf16_t*)(ws + WS_B), (const bf16_t*)(ws + WS_WCAT), M, DM, 512, DM, DM}; pg8::PairOrder S; S.base.init(M, DM, G, (int)blockIdx.x); S.khalf = 512;
        EpiMerge E{(const bf16_t*)(ws + WS_Z), (bf16_t*)(ws + WS_A)};
        pg8::gemm_phase<EpiMerge, pg8::PairOrder>(lds, g, S, E);
    }
    SEAM(5);
    if (IN(6)) {
        pg8::Gemm g{(const bf16_t*)(ws + WS_A), (const bf16_t*)(ws + WS_WOUT), M, DM, DM, DM, DM}; pg8::StaticOrder S; S.init(M, DM, G, (int)blockIdx.x);
        EpiOut E{P.x, P.out, (bf16_t*)(ws + WS_B), (float*)(ws + WS_SSQ)};
        pg8::gemm_phase<EpiOut, pg8::StaticOrder>(lds, g, S, E);
    }
    SEAM(6);
    if (IN(7)) {
        pg8::Gemm g{(const bf16_t*)(ws + WS_B), (const bf16_t*)(ws + WS_WGU), M, 2 * DFF, DM, DM, DM}; pg8::StaticOrder S; S.init(M, 2 * DFF, G, (int)blockIdx.x);
        EpiGU E{(const float*)(ws + WS_SSQ), (bf16_t*)(ws + WS_Z)};
        pg8::gemm_phase<EpiGU, pg8::StaticOrder>(lds, g, S, E);
    }
    SEAM(7);
    if (IN(8)) {
        pg8::Gemm g{(const bf16_t*)(ws + WS_Z), (const bf16_t*)(ws + WS_WDN), M, DM, DFF, DFF, DFF}; pg8::StaticOrder S; S.init(M, DM, G, (int)blockIdx.x);
        EpiDown E{P.out};
        pg8::gemm_phase<EpiDown, pg8::StaticOrder>(lds, g, S, E);
    }
#undef IN
#undef SEAM
}

extern "C" void kernel_launch(void* const* d_in, const int* in_sizes, int n_in, void* d_out, int out_size, void* d_ws, size_t ws_size, hipStream_t stream) {
    static int grid = 0;
    if (grid == 0) {
        if (n_in != 14 || in_sizes[0] != M * DM || out_size != M * DM || ws_size < WS_END) { fprintf(stderr, "kernel_launch: unexpected shapes (n_in %d, ws %zu)\n", n_in, ws_size); grid = -1; return; }
        int dev = 0, cus = 0, per_cu = 0;
        (void)hipGetDevice(&dev); (void)hipDeviceGetAttribute(&cus, hipDeviceAttributeMultiprocessorCount, dev);
        (void)hipFuncSetAttribute((const void*)fwd_megakernel, hipFuncAttributeMaxDynamicSharedMemorySize, LDS_BYTES);
        (void)hipOccupancyMaxActiveBlocksPerMultiprocessor(&per_cu, (const void*)fwd_megakernel, 512, LDS_BYTES);
        if (per_cu < 1) per_cu = 1;
        grid = cus * per_cu; (void)hipGetLastError();
    }
    if (grid < 0) return;
    Params p{};
    p.x = (const float*)d_in[0]; p.g_mix = (const float*)d_in[1]; p.w_in = (const float*)d_in[2]; p.b_forget = (const float*)d_in[3]; p.g_ret_norm = (const float*)d_in[4];
    p.w_ret_o = (const float*)d_in[5]; p.g_fox_q = (const float*)d_in[6]; p.g_fox_k = (const float*)d_in[7]; p.w_fox_o = (const float*)d_in[8]; p.w_out = (const float*)d_in[9];
    p.g_ffn = (const float*)d_in[10]; p.w_gate = (const float*)d_in[11]; p.w_up = (const float*)d_in[12]; p.w_down = (const float*)d_in[13];
    p.out = (float*)d_out; p.ws = (unsigned char*)d_ws;
#if MK_N_LAUNCHES == 1
    p.ph_lo = 0; p.ph_hi = NPHASE;
    void* args[] = {&p};
    hipError_t e = hipLaunchCooperativeKernel((const void*)fwd_megakernel, dim3(grid), dim3(512), args, LDS_BYTES, stream);
    if (e != hipSuccess) fprintf(stderr, "cooperative launch failed: %s (grid %d)\n", hipGetErrorString(e), grid);
#else
    for (int k = 0; k < NPHASE; ++k) { p.ph_lo = k; p.ph_hi = k + 1; hipLaunchKernelGGL(fwd_megakernel, dim3(grid), dim3(512), LDS_BYTES, stream, p); }
#endif
}
```

```cpp
#include <hip/hip_runtime.h>
#include <hip/hip_cooperative_groups.h>
#include <cstdio>
#include <cstdint>
namespace cg = cooperative_groups;

#ifndef MK_N_LAUNCHES
#define MK_N_LAUNCHES 1
#endif

#define LAS __attribute__((address_space(3)))
typedef unsigned short bf16_t;
typedef short bf16x8 __attribute__((ext_vector_type(8)));
typedef short s16x4 __attribute__((ext_vector_type(4)));
typedef float f32x4 __attribute__((ext_vector_type(4)));
typedef float f32x2 __attribute__((ext_vector_type(2)));
typedef float f32x16 __attribute__((ext_vector_type(16)));
typedef unsigned u32x4 __attribute__((ext_vector_type(4)));
typedef unsigned u32x2 __attribute__((ext_vector_type(2)));

constexpr int M = 65536, DM = 1024, SEQ = 8192, NBATCH = 8;
constexpr int ZP = 5120;
constexpr int QR_OFF = 0, KR_OFF = 256, VR_OFF = 512, GR_OFF = 1024, QF_OFF = 1536, KF_OFF = 2048, VF_OFF = 2560, AR_OFF = 3072, AF_OFF = 4096;
constexpr int INC = 5128;
constexpr int DFF = 2816;
constexpr float EPS = 1e-6f;
constexpr float LOG2E = 1.4426950408889634f;
constexpr float C2 = 0.125f * LOG2E;

constexpr size_t MiB = 1u << 20;
constexpr size_t WS_WIN = 0, WS_WCAT = 10 * MiB, WS_WOUT = 12 * MiB, WS_WGU = 14 * MiB, WS_WDN = 25 * MiB;
constexpr size_t WS_ROPE = 31 * MiB, WS_LOGF = 33 * MiB, WS_C2 = 35 * MiB, WS_SSQ = 37 * MiB;
constexpr size_t WS_Z = 48 * MiB;
constexpr size_t WS_A = 688 * MiB;
constexpr size_t WS_B = 816 * MiB;
constexpr size_t WS_END = 944 * MiB;
constexpr int LDS_BYTES = 147456;

__device__ __forceinline__ unsigned cvtpk(float lo, float hi) { typedef __bf16 b2 __attribute__((ext_vector_type(2))); f32x2 v = {lo, hi}; b2 b = __builtin_convertvector(v, b2); return __builtin_bit_cast(unsigned, b); }
__device__ __forceinline__ float bflo(unsigned w) { return __uint_as_float(w << 16); }
__device__ __forceinline__ float bfhi(unsigned w) { return __uint_as_float(w & 0xffff0000u); }
__device__ __forceinline__ float wave_sum(float v) {
#pragma unroll
    for (int o = 1; o < 64; o <<= 1) v += __shfl_xor(v, o);
    return v;
}
__device__ __forceinline__ float sigmoidf_(float v) { return __builtin_amdgcn_rcpf(1.f + __builtin_amdgcn_exp2f(-v * LOG2E)); }
__device__ __forceinline__ int crow(int r, int hi) { return (r & 3) + 8 * (r >> 2) + 4 * hi; }
#define MFMA32(a, b, c) __builtin_amdgcn_mfma_f32_32x32x16_bf16((a), (b), (c), 0, 0, 0)
typedef short v4i16_t __attribute__((ext_vector_type(4)));
__device__ __forceinline__ s16x4 vtr(const LAS unsigned char* p) { return __builtin_bit_cast(s16x4, __builtin_amdgcn_ds_read_tr16_b64_v4i16((LAS v4i16_t*)p)); }
__device__ __forceinline__ bf16x8 cat8(s16x4 lo, s16x4 hi) { return (bf16x8){lo[0], lo[1], lo[2], lo[3], hi[0], hi[1], hi[2], hi[3]}; }
__device__ __forceinline__ bf16x8 pack8(const f32x16& x, int b) {
    u32x4 p; p[0] = cvtpk(x[b], x[b + 1]); p[1] = cvtpk(x[b + 2], x[b + 3]); p[2] = cvtpk(x[b + 4], x[b + 5]); p[3] = cvtpk(x[b + 6], x[b + 7]);
    return __builtin_bit_cast(bf16x8, p);
}

namespace pg8 {
constexpr int BM = 256, BK = 64, HALF = 128, HTB = HALF * BK * 2, STAGE_BYTES = 8 * HTB, NXCD = 8, WGM = 8;
__host__ __device__ __forceinline__ int lds_byte(int r, int c) { const int st = (r >> 4) * 2 + (c >> 5), rr = r & 15, cc = c & 31, ob = rr * 64 + cc * 2; return st * 1024 + (ob ^ (((ob >> 9) & 1) << 5)); }
__host__ __device__ __forceinline__ void stage_rc(int b, int& R, int& C) { const int st = b / 1024, sb = b % 1024, swz = sb ^ (((sb >> 9) & 1) << 5); R = (st >> 1) * 16 + swz / 64; C = (st & 1) * 32 + (swz % 64) / 2; }
__host__ __device__ __forceinline__ int perm32(int rho) { const int n = rho >> 4, i = rho & 15; return 8 * (i >> 2) + 4 * n + (i & 3); }
struct Unit { int pm, pn, kq, fin; };
struct Gemm { const bf16_t* A; const bf16_t* Bt; int M, N, K, lda, ldb; };
struct StaticOrder {
    int nM, nN, nwg, G, c;
    __device__ void init(int M_, int N_, int G_, int c_) { nM = M_ / BM; nN = N_ / BM; nwg = nM * nN; G = G_; c = c_; }
    __device__ bool next(int i, Unit& u) const {
        const long L = (long)i * G + c; if (L >= nwg) return false;
        int wgid = (int)L; { const int q = nwg / NXCD, r = nwg % NXCD, xcd = wgid % NXCD, off = wgid / NXCD; wgid = (xcd < r ? xcd * (q + 1) : r * (q + 1) + (xcd - r) * q) + off; }
        const int nig = WGM * nN, gid = wgid / nig, fm = gid * WGM, gsz = (nM - fm) < WGM ? (nM - fm) : WGM;
        u.pm = fm + ((wgid % nig) % gsz); u.pn = (wgid % nig) / gsz; u.kq = 0; u.fin = 1; return true;
    }
};
struct PairOrder {
    StaticOrder base; int khalf;
    __device__ bool next(int i, Unit& u) const { if (!base.next(i >> 1, u)) return false; u.kq = (i & 1) * khalf; u.fin = i & 1; return true; }
};
template <class Epi, class Sched>
__device__ __forceinline__ void gemm_phase(LAS unsigned char* lds, const Gemm g, const Sched& S, const Epi& E) {
    const int tid = threadIdx.x, wid = __builtin_amdgcn_readfirstlane(tid >> 6), lane = tid & 63, wr = wid >> 2, wc = wid & 3, fr = lane & 15, fq = lane >> 4;
    const int K = g.K, nt = K / BK;
    unsigned voffA[2], voffB[2];
#pragma unroll
    for (int i = 0; i < 2; ++i) { int R, C; stage_rc(tid * 16 + i * 8192, R, C); const int Rb = Epi::PERM ? ((R & ~31) + perm32(R & 31)) : R;
        voffA[i] = (unsigned)(R * g.lda + C) * 2u; voffB[i] = (unsigned)(Rb * g.ldb + C) * 2u; }
    const size_t kstep = (size_t)(BK * 2);
    const size_t hstepA = (size_t)HALF * g.lda * 2, tstepA = 2 * hstepA, hstepB = (size_t)HALF * g.ldb * 2, tstepB = 2 * hstepB;
    const unsigned ldsw = (unsigned)wid * 1024u;
    const int aoff = lds_byte(wr * 64 + fr, fq * 8), boff = lds_byte(wc * 32 + fr, fq * 8);
#define PG8_SA(b, h) (((b) * 2 + (h)) * HTB)
#define PG8_SB(b, h) ((4 + (b) * 2 + (h)) * HTB)
#define PG8_STAGE(bufoff, gbase, voff) do { _Pragma("unroll") for (int _i = 0; _i < 2; ++_i) \
        __builtin_amdgcn_global_load_lds((const unsigned*)((const char*)(gbase) + (voff)[_i]), (LAS unsigned*)(lds + (bufoff) + ldsw + _i * 8192), 16, 0, 0); } while (0)
#define PG8_LDA(dst, b, h) do { _Pragma("unroll") for (int m = 0; m < 4; ++m) _Pragma("unroll") for (int k = 0; k < 2; ++k) dst[m][k] = *(const LAS bf16x8*)(lds + PG8_SA(b, h) + aoff + m * 2048 + k * 1024); } while (0)
#define PG8_LDB(dst, b, h) do { _Pragma("unroll") for (int n = 0; n < 2; ++n) _Pragma("unroll") for (int k = 0; k < 2; ++k) dst[n][k] = *(const LAS bf16x8*)(lds + PG8_SB(b, h) + boff + n * 2048 + k * 1024); } while (0)
#define PG8_MMA(ai, bj, At, Bt) do { __builtin_amdgcn_s_setprio(1); _Pragma("unroll") for (int m = 0; m < 4; ++m) _Pragma("unroll") for (int n = 0; n < 2; ++n) _Pragma("unroll") for (int k = 0; k < 2; ++k) \
        acc[ai][bj][m][n] = __builtin_amdgcn_mfma_f32_16x16x32_bf16(Bt[n][k], At[m][k], acc[ai][bj][m][n], 0, 0, 0); __builtin_amdgcn_s_setprio(0); } while (0)
#define PG8_WAIT_V(n) asm volatile("s_waitcnt vmcnt(" #n ")" ::: "memory")
#define PG8_WAIT_L(n) asm volatile("s_waitcnt lgkmcnt(" #n ")" ::: "memory")
#define PG8_BAR __builtin_amdgcn_s_barrier()
#define PG8_SCHED __builtin_amdgcn_sched_barrier(0)
    Unit cur, nxt; int ui = 0;
    if (!S.next(0, cur)) return;
    f32x4 acc[2][2][4][2];
#pragma unroll
    for (int a = 0; a < 2; ++a)
#pragma unroll
        for (int b = 0; b < 2; ++b)
#pragma unroll
            for (int m = 0; m < 4; ++m)
#pragma unroll
                for (int n = 0; n < 2; ++n) acc[a][b][m][n] = (f32x4){0.f, 0.f, 0.f, 0.f};
    bf16x8 At[4][2], B0[2][2], B1[2][2];
    const char* cA = (const char*)g.A + (size_t)cur.pm * tstepA + (size_t)cur.kq * 2; const char* cB = (const char*)g.Bt + (size_t)cur.pn * tstepB + (size_t)cur.kq * 2;
    PG8_STAGE(PG8_SB(0, 0), cB, voffB); PG8_STAGE(PG8_SB(0, 1), cB + hstepB, voffB); PG8_STAGE(PG8_SA(0, 0), cA, voffA); PG8_STAGE(PG8_SA(0, 1), cA + hstepA, voffA);
    if (wr == 1) PG8_BAR;
    PG8_WAIT_V(2); PG8_BAR;
    PG8_STAGE(PG8_SB(1, 0), cB + kstep, voffB); PG8_STAGE(PG8_SA(1, 0), cA + kstep, voffA); PG8_STAGE(PG8_SB(1, 1), cB + hstepB + kstep, voffB);
    PG8_WAIT_V(6); PG8_BAR;
    for (;;) {
        const bool has_next = S.next(ui + 1, nxt);
        const char* nA = has_next ? (const char*)g.A + (size_t)nxt.pm * tstepA + (size_t)nxt.kq * 2 : cA; const char* nB = has_next ? (const char*)g.Bt + (size_t)nxt.pn * tstepB + (size_t)nxt.kq * 2 : cB;
        for (int t = 0; t < nt; t += 2) {
            const bool last = (t == nt - 2);
            const char* a1 = cA + (size_t)(t + 1) * kstep;
            const char* a2 = last ? nA : cA + (size_t)(t + 2) * kstep; const char* b2 = last ? nB : cB + (size_t)(t + 2) * kstep;
            const char* a3 = a2 + kstep; const char* b3 = b2 + kstep;
            PG8_LDB(B0, 0, 0); PG8_LDB(B1, 0, 1); PG8_SCHED; PG8_LDA(At, 0, 0); PG8_STAGE(PG8_SA(1, 1), a1 + hstepA, voffA);
            PG8_WAIT_V(8); PG8_WAIT_L(0); PG8_BAR; PG8_MMA(0, 0, At, B0); PG8_MMA(0, 1, At, B1); PG8_BAR; PG8_SCHED;
            PG8_LDA(At, 0, 1); PG8_STAGE(PG8_SB(0, 0), b2, voffB); PG8_STAGE(PG8_SB(0, 1), b2 + hstepB, voffB); PG8_STAGE(PG8_SA(0, 0), a2, voffA);
            PG8_WAIT_V(8); PG8_WAIT_L(0); PG8_BAR; PG8_MMA(1, 0, At, B0); PG8_MMA(1, 1, At, B1); PG8_BAR; PG8_SCHED;
            PG8_LDB(B0, 1, 0); PG8_LDB(B1, 1, 1); PG8_SCHED; PG8_LDA(At, 1, 0); PG8_STAGE(PG8_SA(0, 1), a2 + hstepA, voffA);
            PG8_WAIT_V(8); PG8_WAIT_L(0); PG8_BAR; PG8_MMA(0, 0, At, B0); PG8_MMA(0, 1, At, B1); PG8_BAR; PG8_SCHED;
            PG8_LDA(At, 1, 1); PG8_STAGE(PG8_SB(1, 0), b3, voffB); PG8_STAGE(PG8_SB(1, 1), b3 + hstepB, voffB); PG8_STAGE(PG8_SA(1, 0), a3, voffA);
            PG8_WAIT_V(8); PG8_WAIT_L(0); PG8_BAR; PG8_MMA(1, 0, At, B0); PG8_MMA(1, 1, At, B1); PG8_BAR; PG8_SCHED;
        }
        if (wr == 0) PG8_BAR;
        const bool keep = Epi::MID && !cur.fin;
        if (keep) E.mid(acc, cur, wr, wc, fr, fq); else E(acc, cur, wr, wc, fr, fq);
        if (!has_next) break;
        if (!keep)
#pragma unroll
        for (int a = 0; a < 2; ++a)
#pragma unroll
            for (int b = 0; b < 2; ++b)
#pragma unroll
                for (int m = 0; m < 4; ++m)
#pragma unroll
                    for (int n = 0; n < 2; ++n) acc[a][b][m][n] = (f32x4){0.f, 0.f, 0.f, 0.f};
        cur = nxt; cA = nA; cB = nB; ++ui;
        if (wr == 1) PG8_BAR;
    }
    PG8_WAIT_V(0);
    PG8_BAR;
#undef PG8_SA
#undef PG8_SB
#undef PG8_STAGE
#undef PG8_LDA
#undef PG8_LDB
#undef PG8_MMA
#undef PG8_WAIT_V
#undef PG8_WAIT_L
#undef PG8_BAR
#undef PG8_SCHED
}
}
using pg8::Unit;

struct EpiZ {
    static constexpr bool PERM = true, MID = false;
    bf16_t* Z; const float* rope; const float* gq; const float* gk;
    __device__ __forceinline__ void mid(f32x4 (&)[2][2][4][2], const Unit&, int, int, int, int) const {}
    __device__ __forceinline__ void operator()(const f32x4 (&acc)[2][2][4][2], const Unit& u, int wr, int wc, int fr, int fq) const {
        const int T = u.pn; const int row0 = u.pm * 256 + wr * 64 + fr; const int colp = wc * 32 + 8 * fq;
        if (T < 2) {
            const int i4 = 4 * (wc & 1) + fq;
            float lg[2];
#pragma unroll
            for (int bj = 0; bj < 2; ++bj) { const int head = 2 * bj + (wc >> 1); lg[bj] = log2f(1.f - exp2f(-5.f - (float)head)); }
#pragma unroll
            for (int ai = 0; ai < 2; ++ai)
#pragma unroll
                for (int m = 0; m < 4; ++m) {
                    const int row = row0 + ai * 128 + m * 16; const int t = row & (SEQ - 1); const float il = (float)(row & 127);
                    const f32x4* rp = (const f32x4*)(rope + ((size_t)t * 32 + 4 * i4) * 2); const f32x4 c0 = rp[0], c1 = rp[1];
                    const float cs[4] = {c0[0], c0[2], c1[0], c1[2]}, sn[4] = {c0[1], c0[3], c1[1], c1[3]};
#pragma unroll
                    for (int bj = 0; bj < 2; ++bj) {
                        const f32x4 x1 = acc[ai][bj][m][0], x2 = acc[ai][bj][m][1];
                        const float sc = (T == 0) ? exp2f(il * lg[bj]) : 0.125f * exp2f(-il * lg[bj]);
                        float y1[4], y2[4];
#pragma unroll
                        for (int k = 0; k < 4; ++k) { y1[k] = (x1[k] * cs[k] - x2[k] * sn[k]) * sc; y2[k] = (x1[k] * sn[k] + x2[k] * cs[k]) * sc; }
                        u32x4 w; w[0] = cvtpk(y1[0], y1[1]); w[1] = cvtpk(y1[2], y1[3]); w[2] = cvtpk(y2[0], y2[1]); w[3] = cvtpk(y2[2], y2[3]);
                        *(u32x4*)(Z + (size_t)row * ZP + 256 * T + 128 * bj + colp) = w;
                    }
                }
        } else if (T >= 6 && T < 10) {
            const bool isq = T < 8; const float* g = isq ? gq : gk; const float sc = isq ? C2 : 1.f;
            f32x4 gv[2][2];
#pragma unroll
            for (int bj = 0; bj < 2; ++bj)
#pragma unroll
                for (int n = 0; n < 2; ++n) gv[bj][n] = *(const f32x4*)(g + 32 * bj + 8 * fq + 4 * n);
#pragma unroll
            for (int ai = 0; ai < 2; ++ai)
#pragma unroll
                for (int m = 0; m < 4; ++m) {
                    const int row = row0 + ai * 128 + m * 16; float ss = 0.f;
#pragma unroll
                    for (int bj = 0; bj < 2; ++bj)
#pragma unroll
                        for (int n = 0; n < 2; ++n) { const f32x4 v = acc[ai][bj][m][n]; ss += (v[0] * v[0] + v[1] * v[1]) + (v[2] * v[2] + v[3] * v[3]); }
                    ss += __shfl_xor(ss, 16); ss += __shfl_xor(ss, 32);
                    const float rs = rsqrtf(ss * (1.f / 64.f) + EPS) * sc;
#pragma unroll
                    for (int bj = 0; bj < 2; ++bj) {
                        const f32x4 v0 = acc[ai][bj][m][0] * rs * gv[bj][0], v1 = acc[ai][bj][m][1] * rs * gv[bj][1];
                        u32x4 w; w[0] = cvtpk(v0[0], v0[1]); w[1] = cvtpk(v0[2], v0[3]); w[2] = cvtpk(v1[0], v1[1]); w[3] = cvtpk(v1[2], v1[3]);
                        *(u32x4*)(Z + (size_t)row * ZP + 256 * T + 64 * wc + 32 * bj + 8 * fq) = w;
                    }
                }
        } else if (T >= 12) {
            const int cg_ = 128 * (T - 12) + colp;
#pragma unroll
            for (int ai = 0; ai < 2; ++ai)
#pragma unroll
                for (int m = 0; m < 4; ++m) {
                    const int row = row0 + ai * 128 + m * 16; float rt[8], sf[8];
#pragma unroll
                    for (int n = 0; n < 2; ++n)
#pragma unroll
                        for (int k = 0; k < 4; ++k) { const float er = __builtin_amdgcn_exp2f(-acc[ai][0][m][n][k] * LOG2E), ef = __builtin_amdgcn_exp2f(-fmaxf(acc[ai][1][m][n][k], -60.f) * LOG2E);
                            rt[4 * n + k] = (1.f + ef) * __builtin_amdgcn_rcpf(1.f + er); sf[4 * n + k] = __builtin_amdgcn_rcpf(1.f + ef); }
                    u32x4 w; w[0] = cvtpk(rt[0], rt[1]); w[1] = cvtpk(rt[2], rt[3]); w[2] = cvtpk(rt[4], rt[5]); w[3] = cvtpk(rt[6], rt[7]);
                    *(u32x4*)(Z + (size_t)row * ZP + AR_OFF + cg_) = w;
                    w[0] = cvtpk(sf[0], sf[1]); w[1] = cvtpk(sf[2], sf[3]); w[2] = cvtpk(sf[4], sf[5]); w[3] = cvtpk(sf[6], sf[7]);
                    *(u32x4*)(Z + (size_t)row * ZP + AF_OFF + cg_) = w;
                }
        } else {
            const int mode = (T == 4 || T == 5) ? 1 : 0;
#pragma unroll
            for (int ai = 0; ai < 2; ++ai)
#pragma unroll
                for (int m = 0; m < 4; ++m) {
                    const int row = row0 + ai * 128 + m * 16;
#pragma unroll
                    for (int bj = 0; bj < 2; ++bj) {
                        f32x4 v0 = acc[ai][bj][m][0], v1 = acc[ai][bj][m][1];
                        if (mode) {
#pragma unroll
                            for (int k = 0; k < 4; ++k) { const float s0 = sigmoidf_(v0[k]), s1 = sigmoidf_(v1[k]); v0[k] = (mode == 1) ? v0[k] * s0 : s0; v1[k] = (mode == 1) ? v1[k] * s1 : s1; }
                        }
                        u32x4 w; w[0] = cvtpk(v0[0], v0[1]); w[1] = cvtpk(v0[2], v0[3]); w[2] = cvtpk(v1[0], v1[1]); w[3] = cvtpk(v1[2], v1[3]);
                        *(u32x4*)(Z + (size_t)row * ZP + 256 * T + 128 * bj + colp) = w;
                    }
                }
        }
    }
};
struct EpiMerge {
    static constexpr bool PERM = true, MID = true;
    const bf16_t* Z; bf16_t* MG;
    __device__ __forceinline__ void mid(f32x4 (&acc)[2][2][4][2], const Unit& u, int wr, int wc, int fr, int fq) const {
        const int row0 = u.pm * 256 + wr * 64 + fr; const int col0 = u.pn * 256 + wc * 32 + 8 * fq;
#pragma unroll
        for (int ai = 0; ai < 2; ++ai)
#pragma unroll
            for (int m = 0; m < 4; ++m)
#pragma unroll
                for (int bj = 0; bj < 2; ++bj) {
                    const bf16_t* zp = Z + (size_t)(row0 + ai * 128 + m * 16) * ZP + col0 + 128 * bj;
                    const u32x4 a = *(const u32x4*)(zp + AR_OFF);
#pragma unroll
                    for (int k = 0; k < 2; ++k) {
                        acc[ai][bj][m][0][2 * k] *= bflo(a[k]); acc[ai][bj][m][0][2 * k + 1] *= bfhi(a[k]);
                        acc[ai][bj][m][1][2 * k] *= bflo(a[2 + k]); acc[ai][bj][m][1][2 * k + 1] *= bfhi(a[2 + k]);
                    }
                }
    }
    __device__ __forceinline__ void operator()(const f32x4 (&acc)[2][2][4][2], const Unit& u, int wr, int wc, int fr, int fq) const {
        const int row0 = u.pm * 256 + wr * 64 + fr; const int col0 = u.pn * 256 + wc * 32 + 8 * fq;
#pragma unroll
        for (int ai = 0; ai < 2; ++ai)
#pragma unroll
            for (int m = 0; m < 4; ++m)
#pragma unroll
                for (int bj = 0; bj < 2; ++bj) {
                    const int row = row0 + ai * 128 + m * 16;
                    const u32x4 f = *(const u32x4*)(Z + (size_t)row * ZP + col0 + 128 * bj + AF_OFF);
                    const f32x4 v0 = acc[ai][bj][m][0], v1 = acc[ai][bj][m][1];
                    u32x4 w; w[0] = cvtpk(v0[0] * bflo(f[0]), v0[1] * bfhi(f[0])); w[1] = cvtpk(v0[2] * bflo(f[1]), v0[3] * bfhi(f[1]));
                    w[2] = cvtpk(v1[0] * bflo(f[2]), v1[1] * bfhi(f[2])); w[3] = cvtpk(v1[2] * bflo(f[3]), v1[3] * bfhi(f[3]));
                    *(u32x4*)(MG + (size_t)row * DM + col0 + 128 * bj) = w;
                }
    }
};
struct EpiOut {
    static constexpr bool PERM = false, MID = false;
    const float* x; bf16_t* X1B; float* SSQ;
    __device__ __forceinline__ void mid(f32x4 (&)[2][2][4][2], const Unit&, int, int, int, int) const {}
    __device__ __forceinline__ void operator()(const f32x4 (&acc)[2][2][4][2], const Unit& u, int wr, int wc, int fr, int fq) const {
        const int row0 = u.pm * 256 + wr * 64 + fr; const int col0 = u.pn * 256 + wc * 32 + 4 * fq;
#pragma unroll
        for (int ai = 0; ai < 2; ++ai)
#pragma unroll
            for (int m = 0; m < 4; ++m) {
                const int row = row0 + ai * 128 + m * 16; const size_t off = (size_t)row * DM + col0; float ss = 0.f;
#pragma unroll
                for (int bj = 0; bj < 2; ++bj)
#pragma unroll
                    for (int n = 0; n < 2; ++n) {
                        const f32x4 v = *(const f32x4*)(x + off + bj * 128 + n * 16) + acc[ai][bj][m][n];
                        u32x2 w; w[0] = cvtpk(v[0], v[1]); w[1] = cvtpk(v[2], v[3]); *(u32x2*)(X1B + off + bj * 128 + n * 16) = w;
                        ss += (v[0] * v[0] + v[1] * v[1]) + (v[2] * v[2] + v[3] * v[3]);
                    }
                ss += __shfl_xor(ss, 16); ss += __shfl_xor(ss, 32);
                if (fq == 0) SSQ[(size_t)row * 16 + u.pn * 4 + wc] = ss;
            }
    }
};
struct EpiGU {
    static constexpr bool PERM = true, MID = false;
    const float* SSQ; bf16_t* HID;
    __device__ __forceinline__ void mid(f32x4 (&)[2][2][4][2], const Unit&, int, int, int, int) const {}
    __device__ __forceinline__ void operator()(const f32x4 (&acc)[2][2][4][2], const Unit& u, int wr, int wc, int fr, int fq) const {
        const int row0 = u.pm * 256 + wr * 64 + fr; const int col0 = u.pn * 128 + wc * 32 + 8 * fq;
#pragma unroll
        for (int ai = 0; ai < 2; ++ai)
#pragma unroll
            for (int m = 0; m < 4; ++m) {
                const int row = row0 + ai * 128 + m * 16;
                const f32x4* sp = (const f32x4*)(SSQ + (size_t)row * 16); const f32x4 s0 = sp[0], s1 = sp[1], s2 = sp[2], s3 = sp[3];
                const float ss = (((s0[0] + s0[1]) + (s0[2] + s0[3])) + ((s1[0] + s1[1]) + (s1[2] + s1[3]))) + (((s2[0] + s2[1]) + (s2[2] + s2[3])) + ((s3[0] + s3[1]) + (s3[2] + s3[3])));
                const float rs = rsqrtf(ss * (1.f / 1024.f) + EPS);
                float hv[8];
#pragma unroll
                for (int n = 0; n < 2; ++n)
#pragma unroll
                    for (int k = 0; k < 4; ++k) { const float gte = acc[ai][0][m][n][k] * rs, up = acc[ai][1][m][n][k] * rs; hv[4 * n + k] = gte * sigmoidf_(gte) * up; }
                u32x4 w; w[0] = cvtpk(hv[0], hv[1]); w[1] = cvtpk(hv[2], hv[3]); w[2] = cvtpk(hv[4], hv[5]); w[3] = cvtpk(hv[6], hv[7]);
                *(u32x4*)(HID + (size_t)row * DFF + col0) = w;
            }
    }
};
struct EpiDown {
    static constexpr bool PERM = false, MID = false;
    const bf16_t* X1B; float* out;
    __device__ __forceinline__ void mid(f32x4 (&)[2][2][4][2], const Unit&, int, int, int, int) const {}
    __device__ __forceinline__ void operator()(const f32x4 (&acc)[2][2][4][2], const Unit& u, int wr, int wc, int fr, int fq) const {
        const int row0 = u.pm * 256 + wr * 64 + fr; const int col0 = u.pn * 256 + wc * 32 + 4 * fq;
#pragma unroll
        for (int ai = 0; ai < 2; ++ai)
#pragma unroll
            for (int m = 0; m < 4; ++m) {
                const size_t off = (size_t)(row0 + ai * 128 + m * 16) * DM + col0;
#pragma unroll
                for (int bj = 0; bj < 2; ++bj)
#pragma unroll
                    for (int n = 0; n < 2; ++n) { const u32x2 xb = *(const u32x2*)(X1B + off + bj * 128 + n * 16); const f32x4 xr = {bflo(xb[0]), bfhi(xb[0]), bflo(xb[1]), bfhi(xb[1])};
                        *(f32x4*)(out + off + bj * 128 + n * 16) = xr + acc[ai][bj][m][n]; }
            }
    }
};

struct Params {
    const float *x, *g_mix, *w_in, *b_forget, *g_ret_norm, *w_ret_o, *g_fox_q, *g_fox_k, *w_fox_o, *w_out, *g_ffn, *w_gate, *w_up, *w_down;
    float* out; unsigned char* ws; int ph_lo, ph_hi;
};

__device__ __forceinline__ int win_src(int np) {
    const int T = np >> 8, p = np & 255;
    if (T < 2) { const int head = p >> 6, w = p & 63, i = w >> 3, j = w & 7; const int d = (j < 4) ? (4 * i + j) : (32 + 4 * i + (j - 4)); return T * 256 + head * 64 + d; }
    if (T >= 6 && T < 10) { const int hit = (p & 127) >> 5, d = 32 * (p >> 7) + (p & 31); return 256 * T + hit * 64 + d; }
    if (T >= 12) { const int c = 128 * (T - 12) + (p & 127); return ((p >> 7) ? 4104 : 3080) + c; }
    return np;
}
__device__ __forceinline__ void transpose_tile(LAS float* scr, const float* W, int pitch, int srccol, const float* kscale, bf16_t* WT, int ldt, int n0, int k0, int koff) {
    const int tid = threadIdx.x;
    { const int nn = tid & 63, kk0 = tid >> 6;
#pragma unroll
      for (int ps = 0; ps < 8; ++ps) { const int kk = kk0 + 8 * ps; scr[kk * 65 + nn] = W[(size_t)(k0 + kk) * pitch + srccol]; } }
    __syncthreads();
    { const int nn = tid >> 3, c = tid & 7; float v[8];
#pragma unroll
      for (int j = 0; j < 8; ++j) { v[j] = scr[(8 * c + j) * 65 + nn]; if (kscale) v[j] *= kscale[k0 + 8 * c + j]; }
      u32x4 o; o[0] = cvtpk(v[0], v[1]); o[1] = cvtpk(v[2], v[3]); o[2] = cvtpk(v[4], v[5]); o[3] = cvtpk(v[6], v[7]);
      *(u32x4*)(WT + (size_t)(n0 + nn) * ldt + koff + k0 + 8 * c) = o; }
    __syncthreads();
}
__device__ __forceinline__ void p0_prologue(const Params& P, LAS unsigned char* lds) {
    const int tid = threadIdx.x, lane = tid & 63, wave = tid >> 6, G = gridDim.x;
    unsigned char* ws = P.ws;
    bf16_t* WIN = (bf16_t*)(ws + WS_WIN); bf16_t* WCAT = (bf16_t*)(ws + WS_WCAT); bf16_t* WOUT = (bf16_t*)(ws + WS_WOUT); bf16_t* WGU = (bf16_t*)(ws + WS_WGU); bf16_t* WDN = (bf16_t*)(ws + WS_WDN);
    LAS float* scr = (LAS float*)lds;
    constexpr int T0 = 80 * 16, T1 = 16 * 8, T2 = 16 * 8, T3 = 16 * 16, T4 = 88 * 16, T5 = 16 * 44;
    constexpr int NT = T0 + T1 + T2 + T3 + T4 + T5;
    for (int it = blockIdx.x; it < NT; it += G) {
        int r = it; const int nn = tid & 63;
        if (r < T0) { const int tn = r / 16, tk = r % 16; transpose_tile(scr, P.w_in, INC, win_src(tn * 64 + nn), nullptr, WIN, 1024, tn * 64, tk * 64, 0); continue; } r -= T0;
        if (r < T1) { const int tn = r / 8, tk = r % 8; transpose_tile(scr, P.w_ret_o, 1024, tn * 64 + nn, nullptr, WCAT, 1024, tn * 64, tk * 64, 0); continue; } r -= T1;
        if (r < T2) { const int tn = r / 8, tk = r % 8; transpose_tile(scr, P.w_fox_o, 1024, tn * 64 + nn, nullptr, WCAT, 1024, tn * 64, tk * 64, 512); continue; } r -= T2;
        if (r < T3) { const int tn = r / 16, tk = r % 16; transpose_tile(scr, P.w_out, 1024, tn * 64 + nn, nullptr, WOUT, 1024, tn * 64, tk * 64, 0); continue; } r -= T3;
        if (r < T4) { const int tn = r / 16, tk = r % 16; const int n0 = tn * 64, T = n0 >> 8, p = n0 & 255; const float* W = (p >= 128) ? P.w_up : P.w_gate;
                      transpose_tile(scr, W, DFF, 128 * T + (p & 127) + nn, P.g_ffn, WGU, 1024, n0, tk * 64, 0); continue; } r -= T4;
        { const int tn = r / 44, tk = r % 44; transpose_tile(scr, P.w_down, 1024, tn * 64 + nn, nullptr, WDN, DFF, tn * 64, tk * 64, 0); }
    }
    { float* rope = (float*)(ws + WS_ROPE);
      for (int i = blockIdx.x * 512 + tid; i < SEQ * 32; i += G * 512) {
          const int t = i >> 5, d = i & 31;
          const float inv_freq = 1.0f / exp2f((float)d * (13.287712379549449f / 32.f));
          const float ang = (float)t * inv_freq;
          const double ad = (double)ang; const double nrev = __builtin_rint(ad * 0.15915494309189535); const float rr = (float)(ad - nrev * 6.283185307179586);
          rope[2 * i] = cosf(rr); rope[2 * i + 1] = sinf(rr);
      } }
    LAS float* wf = (LAS float*)(lds + 32768);
    for (int i = tid; i < 8192; i += 512) { const int col = i >> 3; wf[(col >> 2) * 36 + (col & 3) * 8 + (i & 7)] = P.w_in[(size_t)col * INC + 3072 + (i & 7)]; }
    __syncthreads();
    bf16_t* XN = (bf16_t*)(ws + WS_A); float* LOGF = (float*)(ws + WS_LOGF);
    const int gw = blockIdx.x * 8 + wave, NGW = G * 8;
    for (int m = gw; m < M; m += NGW) {
        const f32x4* xr = (const f32x4*)(P.x + (size_t)m * DM) + lane; f32x4 v[4]; float ss = 0.f;
#pragma unroll
        for (int j = 0; j < 4; ++j) { v[j] = xr[64 * j]; ss += (v[j][0] * v[j][0] + v[j][1] * v[j][1]) + (v[j][2] * v[j][2] + v[j][3] * v[j][3]); }
        const float rstd = rsqrtf(wave_sum(ss) * (1.f / DM) + EPS);
        float fa[8];
#pragma unroll
        for (int q = 0; q < 8; ++q) fa[q] = 0.f;
#pragma unroll
        for (int j = 0; j < 4; ++j) {
            const f32x4 gm = ((const f32x4*)P.g_mix)[lane + 64 * j]; v[j] = v[j] * rstd * gm;
            u32x2 w; w[0] = cvtpk(v[j][0], v[j][1]); w[1] = cvtpk(v[j][2], v[j][3]);
            *(u32x2*)(XN + (size_t)m * DM + 4 * lane + 256 * j) = w;
#pragma unroll
            for (int k = 0; k < 4; ++k) { const int wo = (lane + 64 * j) * 36 + k * 8; const f32x4 w0 = *(const LAS f32x4*)(wf + wo), w1 = *(const LAS f32x4*)(wf + wo + 4);
#pragma unroll
                for (int q = 0; q < 4; ++q) { fa[q] += v[j][k] * w0[q]; fa[4 + q] += v[j][k] * w1[q]; } }
        }
#pragma unroll
        for (int q = 0; q < 8; ++q) fa[q] = wave_sum(fa[q]);
        float z = fa[0];
#pragma unroll
        for (int q = 1; q < 8; ++q) z = (lane == q) ? fa[q] : z;
        if (lane < 8) { z += P.b_forget[lane]; const float ls = fminf(z, 0.f) - log1pf(expf(-fabsf(z))); LOGF[(size_t)m * 8 + lane] = ls * LOG2E; }
    }
}

__device__ __forceinline__ void cumsum_c2(const Params& P) {
    const int lane = threadIdx.x & 63, gw = blockIdx.x * 8 + (threadIdx.x >> 6);
    const float* LOGF = (const float*)(P.ws + WS_LOGF); float* Cc = (float*)(P.ws + WS_C2);
    for (int bh = gw; bh < 64; bh += gridDim.x * 8) {
        const int b = bh >> 3, h = bh & 7; const float* src = LOGF + ((size_t)b * SEQ + 128 * lane) * 8 + h;
        float s = 0.f;
        for (int i = 0; i < 128; ++i) s += src[i * 8];
        float inc = s;
#pragma unroll
        for (int o = 1; o < 64; o <<= 1) { const float v = __shfl_up(inc, o); if (lane >= o) inc += v; }
        float run = inc - s; float* dst = Cc + (size_t)bh * SEQ + 128 * lane;
        for (int i = 0; i < 128; ++i) { run += src[i * 8]; dst[i] = run; }
    }
}

constexpr int KS = 144, VS = 272;
__device__ __forceinline__ void ret_kv_phase(const Params& P, LAS unsigned char* lds) {
    const int tid = threadIdx.x, lane = tid & 63, w = __builtin_amdgcn_readfirstlane(tid >> 6), r = lane & 31, h = lane >> 5;
    const int q4 = (lane & 15) >> 2, p4 = lane & 3, g16 = (lane >> 4) & 1;
    const bf16_t* Z = (const bf16_t*)(P.ws + WS_Z); float* KV = (float*)(P.ws + WS_A);
    constexpr int HB = 128 * KS + 128 * VS;
    for (int u = blockIdx.x; u < 1024; u += gridDim.x) {
        const int b = u >> 7, n = (u >> 1) & 63, hp = u & 1; const size_t R0 = (size_t)b * SEQ + (size_t)n * 128;
#pragma unroll
        for (int i = 0; i < 4; ++i) { const int id = tid + 512 * i; const int hh = id >> 10, row = (id >> 3) & 127, ch = id & 7;
            const u32x4 v = *(const u32x4*)(Z + (R0 + row) * ZP + KR_OFF + (2 * hp + hh) * 64 + 8 * ch);
            *(LAS u32x4*)(lds + hh * HB + row * KS + ch * 16) = v; }
#pragma unroll
        for (int i = 0; i < 8; ++i) { const int id = tid + 512 * i; const int hh = id >> 11, row = (id >> 4) & 127, ch = id & 15;
            const u32x4 v = *(const u32x4*)(Z + (R0 + row) * ZP + VR_OFF + (2 * hp + hh) * 128 + 8 * ch);
            *(LAS u32x4*)(lds + hh * HB + 128 * KS + row * VS + ch * 16) = v; }
        __syncthreads();
        const int hh = w >> 2, eb = w & 3, head = 2 * hp + hh;
        const LAS unsigned char* Kt = lds + hh * HB; const LAS unsigned char* Vt = Kt + 128 * KS;
        f32x16 acc[2];
#pragma unroll
        for (int i = 0; i < 16; ++i) { acc[0][i] = 0.f; acc[1][i] = 0.f; }
#pragma unroll
        for (int ks = 0; ks < 8; ++ks) {
            const int jr = 16 * ks + 8 * h + q4;
            const bf16x8 bfv = cat8(vtr(Vt + jr * VS + (32 * eb + 16 * g16 + 4 * p4) * 2), vtr(Vt + (jr + 4) * VS + (32 * eb + 16 * g16 + 4 * p4) * 2));
#pragma unroll
            for (int db = 0; db < 2; ++db) {
                const bf16x8 af = cat8(vtr(Kt + jr * KS + (32 * db + 16 * g16 + 4 * p4) * 2), vtr(Kt + (jr + 4) * KS + (32 * db + 16 * g16 + 4 * p4) * 2));
                acc[db] = MFMA32(af, bfv, acc[db]);
            }
        }
        float* dst = KV + ((size_t)((b * 64 + n) * 4 + head)) * 8192 + 32 * eb + r;
#pragma unroll
        for (int db = 0; db < 2; ++db)
#pragma unroll
            for (int i = 0; i < 16; ++i) dst[(32 * db + crow(i, h)) * 128] = acc[db][i];
        __syncthreads();
    }
}
__device__ __forceinline__ void ret_scan(const Params& P) {
    const float* KV = (const float*)(P.ws + WS_A); bf16_t* ST = (bf16_t*)(P.ws + WS_A + 64 * MiB);
    for (int p = blockIdx.x * 512 + threadIdx.x; p < 131072; p += gridDim.x * 512) {
        const int b = p >> 14, head = (p >> 12) & 3, de = p & 4095;
        const float g = exp2f(128.f * log2f(1.f - exp2f(-5.f - (float)head)));
        float s0 = 0.f, s1 = 0.f;
#pragma unroll 8
        for (int n = 0; n < 64; ++n) {
            const size_t off = ((size_t)((b * 64 + n) * 4 + head)) * 8192 + 2 * de;
            *(unsigned*)(ST + off) = cvtpk(s0, s1);
            const f32x2 kv = *(const f32x2*)(KV + off);
            s0 = g * (s0 + kv[0]); s1 = g * (s1 + kv[1]);
        }
    }
}
constexpr int FOX_BUF = 64 * KS * 2 + 256;
constexpr int FOX_SCR = 2 * FOX_BUF;
__device__ __forceinline__ void fox_phase(const Params& P, LAS unsigned char* lds) {
    const int tid = threadIdx.x, lane = tid & 63, w = __builtin_amdgcn_readfirstlane(tid >> 6), r = lane & 31, h = lane >> 5;
    const bf16_t* Z = (const bf16_t*)(P.ws + WS_Z); const float* Cc = (const float*)(P.ws + WS_C2); bf16_t* OM = (bf16_t*)(P.ws + WS_B);
    float mq = fabsf(P.g_fox_q[lane]), mk = fabsf(P.g_fox_k[lane]);
#pragma unroll
    for (int o = 1; o < 64; o <<= 1) { mq = fmaxf(mq, __shfl_xor(mq, o)); mk = fmaxf(mk, __shfl_xor(mk, o)); }
    const float smax2 = 8.f * mq * mk * LOG2E * 1.02f + 0.25f;
    const float thr = -150.f - 2.f * smax2;
    LAS float* ascr = (LAS float*)(lds + FOX_SCR) + w * 32;
    const int srow = tid >> 3, sch = tid & 7; const int soff = srow * KS + sch * 16;
    const int q4 = (lane & 15) >> 2, p4 = lane & 3, g16 = (lane >> 4) & 1;
    for (int u = blockIdx.x; u < 2048; u += gridDim.x) {
        const int bh = u >> 5, qb = u & 31, b = bh >> 3, hd = bh & 7; const size_t rowbase = (size_t)b * SEQ; const int q0 = qb * 256;
        const float* c2 = Cc + (size_t)bh * SEQ;
        const int nt_all = 4 * qb + 4; const float cq0 = c2[q0];
        int t0;
        { const int t1 = lane, t2 = lane + 64;
          const bool e1 = (t1 < 4 * qb) && (cq0 - c2[64 * t1 + 63] <= thr);
          const bool e2 = (t2 < 4 * qb) && (cq0 - c2[64 * t2 + 63] <= thr);
          t0 = __popcll(__ballot(e1)) + __popcll(__ballot(e2)); }
        t0 = __builtin_amdgcn_readfirstlane(t0);
        const bf16_t* qp = Z + (rowbase + q0 + 32 * w + r) * ZP + QF_OFF + hd * 64 + 8 * h;
        bf16x8 qr[4];
#pragma unroll
        for (int s = 0; s < 4; ++s) qr[s] = *(const bf16x8*)(qp + 16 * s);
        const float cq2 = c2[q0 + 32 * w + r];
        const bf16_t* kg = Z + (rowbase + srow) * ZP + KF_OFF + hd * 64 + 8 * sch;
        u32x4 kreg = *(const u32x4*)(kg + (size_t)t0 * 64 * ZP), vreg = *(const u32x4*)(kg + (size_t)t0 * 64 * ZP + (VF_OFF - KF_OFF));
        float creg = (tid < 64) ? c2[64 * t0 + tid] : 0.f;
        *(LAS u32x4*)(lds + soff) = kreg; *(LAS u32x4*)(lds + 64 * KS + soff) = vreg; if (tid < 64) *(LAS float*)(lds + 128 * KS + 4 * tid) = creg;
        __syncthreads();
        f32x16 o0, o1;
#pragma unroll
        for (int i = 0; i < 16; ++i) { o0[i] = 0.f; o1[i] = 0.f; }
        float m_run = -INFINITY, l_run = 0.f;
        for (int t = t0; t < nt_all; ++t) {
            const int bi = (t - t0) & 1; const bool has_next = t + 1 < nt_all;
            if (has_next) { kreg = *(const u32x4*)(kg + (size_t)(t + 1) * 64 * ZP); vreg = *(const u32x4*)(kg + (size_t)(t + 1) * 64 * ZP + (VF_OFF - KF_OFF)); if (tid < 64) creg = c2[64 * (t + 1) + tid]; }
            const LAS unsigned char* Kb = lds + bi * FOX_BUF; const LAS unsigned char* Vb = Kb + 64 * KS; const LAS float* ckb = (const LAS float*)(Kb + 128 * KS);
            if (64 * t <= q0 + 32 * w + 31) {
                f32x16 p0, p1;
#pragma unroll
                for (int g = 0; g < 4; ++g) { const f32x4 ca = *(const LAS f32x4*)(ckb + 8 * g + 4 * h), cb = *(const LAS f32x4*)(ckb + 32 + 8 * g + 4 * h);
#pragma unroll
                    for (int j = 0; j < 4; ++j) { p0[4 * g + j] = cq2 - ca[j]; p1[4 * g + j] = cq2 - cb[j]; } }
                const LAS unsigned char* kb = Kb + r * KS + h * 16;
#pragma unroll
                for (int s = 0; s < 4; ++s) { const bf16x8 k0 = *(const LAS bf16x8*)(kb + s * 32), k1 = *(const LAS bf16x8*)(kb + 32 * KS + s * 32);
                    p0 = MFMA32(k0, qr[s], p0); p1 = MFMA32(k1, qr[s], p1); }
                if (t >= 4 * qb) { const int qrel = 32 * w + r, kb0 = 64 * (t - 4 * qb) + 4 * h;
#pragma unroll
                    for (int i = 0; i < 16; ++i) { const int kv = kb0 + (i & 3) + 8 * (i >> 2); if (kv > qrel) p0[i] = -INFINITY; if (kv + 32 > qrel) p1[i] = -INFINITY; } }
                float mt = fmaxf(p0[0], p1[0]);
#pragma unroll
                for (int i = 1; i < 16; ++i) mt = fmaxf(mt, fmaxf(p0[i], p1[i]));
                mt = fmaxf(mt, __shfl_xor(mt, 32));
                const float mn = fmaxf(m_run, mt); const float alpha = __builtin_amdgcn_exp2f(m_run - mn); m_run = mn;
                float ps = 0.f;
#pragma unroll
                for (int i = 0; i < 16; ++i) { p0[i] = __builtin_amdgcn_exp2f(p0[i] - mn); p1[i] = __builtin_amdgcn_exp2f(p1[i] - mn); ps += p0[i] + p1[i]; }
                l_run = l_run * alpha + ps;
                if (h == 0) ascr[r] = alpha;
#pragma unroll
                for (int i = 0; i < 16; ++i) { const float a = ascr[crow(i, h)]; o0[i] *= a; o1[i] *= a; }
                bf16x8 pf[4]; pf[0] = pack8(p0, 0); pf[1] = pack8(p0, 8); pf[2] = pack8(p1, 0); pf[3] = pack8(p1, 8);
                const LAS unsigned char* vb = Vb + (4 * h + q4) * KS + g16 * 32 + p4 * 8;
#pragma unroll
                for (int ks = 0; ks < 4; ++ks) {
                    const bf16x8 v0 = cat8(vtr(vb + (16 * ks) * KS), vtr(vb + (16 * ks + 8) * KS));
                    const bf16x8 v1 = cat8(vtr(vb + (16 * ks) * KS + 64), vtr(vb + (16 * ks + 8) * KS + 64));
                    o0 = MFMA32(pf[ks], v0, o0); o1 = MFMA32(pf[ks], v1, o1);
                }
            }
            if (has_next) { LAS unsigned char* nb = lds + (bi ^ 1) * FOX_BUF; *(LAS u32x4*)(nb + soff) = kreg; *(LAS u32x4*)(nb + 64 * KS + soff) = vreg; if (tid < 64) *(LAS float*)(nb + 128 * KS + 4 * tid) = creg; }
            __syncthreads();
        }
        const float lt = l_run + __shfl_xor(l_run, 32);
        if (h == 0) ascr[r] = 1.f / lt;
        bf16_t* op = OM + (rowbase + q0 + 32 * w) * DM + 512 + hd * 64 + r;
#pragma unroll
        for (int i = 0; i < 16; ++i) { const float a = ascr[crow(i, h)]; const int row = crow(i, h);
            op[(size_t)row * DM] = (bf16_t)(cvtpk(o0[i] * a, 0.f) & 0xffffu); op[(size_t)row * DM + 32] = (bf16_t)(cvtpk(o1[i] * a, 0.f) & 0xffffu); }
    }
    __syncthreads();
}
__device__ __forceinline__ void ret_out_phase(const Params& P, LAS unsigned char* lds) {
    const int tid = threadIdx.x, lane = tid & 63, w = __builtin_amdgcn_readfirstlane(tid >> 6), r = lane & 31, h = lane >> 5;
    const int q4 = (lane & 15) >> 2, p4 = lane & 3, g16 = (lane >> 4) & 1;
    const bf16_t* Z = (const bf16_t*)(P.ws + WS_Z); const bf16_t* ST = (const bf16_t*)(P.ws + WS_A + 64 * MiB); bf16_t* OM = (bf16_t*)(P.ws + WS_B);
    constexpr int HB = 128 * KS + 128 * VS + 64 * VS;
    for (int u = blockIdx.x; u < 1024; u += gridDim.x) {
        const int b = u >> 7, n = (u >> 1) & 63, hp = u & 1; const size_t R0 = (size_t)b * SEQ + (size_t)n * 128;
#pragma unroll
        for (int i = 0; i < 4; ++i) { const int id = tid + 512 * i; const int hh = id >> 10, row = (id >> 3) & 127, ch = id & 7;
            const u32x4 v = *(const u32x4*)(Z + (R0 + row) * ZP + KR_OFF + (2 * hp + hh) * 64 + 8 * ch);
            *(LAS u32x4*)(lds + hh * HB + row * KS + ch * 16) = v; }
#pragma unroll
        for (int i = 0; i < 8; ++i) { const int id = tid + 512 * i; const int hh = id >> 11, row = (id >> 4) & 127, ch = id & 15;
            const u32x4 v = *(const u32x4*)(Z + (R0 + row) * ZP + VR_OFF + (2 * hp + hh) * 128 + 8 * ch);
            *(LAS u32x4*)(lds + hh * HB + 128 * KS + row * VS + ch * 16) = v; }
#pragma unroll
        for (int i = 0; i < 4; ++i) { const int id = tid + 512 * i; const int hh = id >> 10, row = (id >> 4) & 63, ch = id & 15;
            const u32x4 v = *(const u32x4*)(ST + ((size_t)((b * 64 + n) * 4 + 2 * hp + hh)) * 8192 + row * 128 + 8 * ch);
            *(LAS u32x4*)(lds + hh * HB + 128 * KS + 128 * VS + row * VS + ch * 16) = v; }
        const int hh = w >> 2, wq = w & 3, head = 2 * hp + hh;
        const bf16_t* qp = Z + (R0 + 32 * wq + r) * ZP + QR_OFF + head * 64 + 8 * h;
        bf16x8 qr[4];
#pragma unroll
        for (int s = 0; s < 4; ++s) qr[s] = *(const bf16x8*)(qp + 16 * s);
        __syncthreads();
        const LAS unsigned char* Kt = lds + hh * HB; const LAS unsigned char* Vt = Kt + 128 * KS; const LAS unsigned char* Sp = Vt + 128 * VS;
        f32x16 o[4];
#pragma unroll
        for (int e = 0; e < 4; ++e)
#pragma unroll
            for (int i = 0; i < 16; ++i) o[e][i] = 0.f;
        const int coff = (16 * g16 + 4 * p4) * 2;
        for (int jb = 0; jb <= wq; ++jb) {
            f32x16 p;
#pragma unroll
            for (int i = 0; i < 16; ++i) p[i] = 0.f;
            const LAS unsigned char* kb = Kt + (32 * jb + r) * KS + h * 16;
#pragma unroll
            for (int s = 0; s < 4; ++s) p = MFMA32(*(const LAS bf16x8*)(kb + s * 32), qr[s], p);
            if (jb == wq) {
#pragma unroll
                for (int i = 0; i < 16; ++i) if (crow(i, h) > r) p[i] = 0.f;
            }
            const bf16x8 pf0 = pack8(p, 0), pf1 = pack8(p, 8);
            const LAS unsigned char* vb = Vt + (32 * jb + 4 * h + q4) * VS + coff;
#pragma unroll
            for (int e = 0; e < 4; ++e) {
                const bf16x8 v0 = cat8(vtr(vb + e * 64), vtr(vb + 8 * VS + e * 64));
                const bf16x8 v1 = cat8(vtr(vb + 16 * VS + e * 64), vtr(vb + 24 * VS + e * 64));
                o[e] = MFMA32(pf0, v0, o[e]); o[e] = MFMA32(pf1, v1, o[e]);
            }
        }
        { const LAS unsigned char* sb = Sp + (8 * h + q4) * VS + coff;
#pragma unroll
          for (int s = 0; s < 4; ++s)
#pragma unroll
              for (int e = 0; e < 4; ++e) { const bf16x8 sf = cat8(vtr(sb + (16 * s) * VS + e * 64), vtr(sb + (16 * s + 4) * VS + e * 64)); o[e] = MFMA32(qr[s], sf, o[e]); } }
        float gn[4];
#pragma unroll
        for (int e = 0; e < 4; ++e) gn[e] = P.g_ret_norm[head * 128 + 32 * e + r];
#pragma unroll
        for (int i = 0; i < 16; ++i) {
            float s1 = (o[0][i] + o[1][i]) + (o[2][i] + o[3][i]);
            float s2 = (o[0][i] * o[0][i] + o[1][i] * o[1][i]) + (o[2][i] * o[2][i] + o[3][i] * o[3][i]);
#pragma unroll
            for (int x = 1; x < 32; x <<= 1) { s1 += __shfl_xor(s1, x); s2 += __shfl_xor(s2, x); }
            const float mu = s1 * (1.f / 128.f); const float var = fmaxf(s2 * (1.f / 128.f) - mu * mu, 0.f); const float rs = rsqrtf(var + EPS);
            const size_t row = R0 + 32 * wq + crow(i, h);
            const bf16_t* gp = Z + row * ZP + GR_OFF + head * 128 + r; bf16_t* op = OM + row * DM + head * 128 + r;
#pragma unroll
            for (int e = 0; e < 4; ++e) { const float gt = __uint_as_float((unsigned)gp[32 * e] << 16); op[32 * e] = (bf16_t)(cvtpk((o[e][i] - mu) * rs * gn[e] * gt, 0.f) & 0xffffu); }
        }
        __syncthreads();
    }
}

constexpr int NPHASE = 9;
__global__ void __launch_bounds__(512, 2) fwd_megakernel(Params P) {
    extern __shared__ __attribute__((aligned(16))) unsigned char lds_raw[];
    LAS unsigned char* lds = (LAS unsigned char*)lds_raw;
    cg::grid_group grid = cg::this_grid();
    unsigned char* ws = P.ws; const int lo = P.ph_lo, hi = P.ph_hi; const int G = gridDim.x;
#ifndef PH_MASK
#define PH_MASK 0x1ff
#endif
#define IN(k) (((PH_MASK >> (k)) & 1) && lo <= (k) && (k) < hi)
#ifndef REP_MASK
#define REP_MASK 0
#endif
#define REPS(k) for (int rep_ = 0; rep_ < 1 + ((REP_MASK >> (k)) & 1); ++rep_)
#define SEAM(k) do { if (IN(k) && IN((k) + 1)) grid.sync(); } while (0)
    if (IN(0)) REPS(0) { p0_prologue(P, lds); __syncthreads(); }
    SEAM(0);
    if (IN(1)) REPS(1) {
        cumsum_c2(P);
        pg8::Gemm g{(const bf16_t*)(ws + WS_A), (const bf16_t*)(ws + WS_WIN), M, ZP, DM, DM, DM}; pg8::StaticOrder S; S.init(M, ZP, G, (int)blockIdx.x);
        EpiZ E{(bf16_t*)(ws + WS_Z), (const float*)(ws + WS_ROPE), P.g_fox_q, P.g_fox_k};
        pg8::gemm_phase<EpiZ, pg8::StaticOrder>(lds, g, S, E);
    }
    SEAM(1);
    if (IN(2)) REPS(2) { ret_kv_phase(P, lds); }
    SEAM(2);
    if (IN(3)) REPS(3) { ret_scan(P); fox_phase(P, lds); }
    SEAM(3);
    if (IN(4)) REPS(4) { ret_out_phase(P, lds); }
    SEAM(4);
    if (IN(5)) REPS(5) {
        pg8::Gemm g{(const bf16_t*)(ws + WS_B), (const bf16_t*)(ws + WS_WCAT), M, DM, 512, DM, DM}; pg8::PairOrder S; S.base.init(M, DM, G, (int)blockIdx.x); S.khalf = 512;
        EpiMerge E{(const bf16_t*)(ws + WS_Z), (bf16_t*)(ws + WS_A)};
        pg8::gemm_phase<EpiMerge, pg8::PairOrder>(lds, g, S, E);
    }
    SEAM(5);
    if (IN(6)) REPS(6) {
        pg8::Gemm g{(const bf16_t*)(ws + WS_A), (const bf16_t*)(ws + WS_WOUT), M, DM, DM, DM, DM}; pg8::StaticOrder S; S.init(M, DM, G, (int)blockIdx.x);
        EpiOut E{P.x, (bf16_t*)(ws + WS_B), (float*)(ws + WS_SSQ)};
        pg8::gemm_phase<EpiOut, pg8::StaticOrder>(lds, g, S, E);
    }
    SEAM(6);
    if (IN(7)) REPS(7) {
        pg8::Gemm g{(const bf16_t*)(ws + WS_B), (const bf16_t*)(ws + WS_WGU), M, 2 * DFF, DM, DM, DM}; pg8::StaticOrder S; S.init(M, 2 * DFF, G, (int)blockIdx.x);
        EpiGU E{(const float*)(ws + WS_SSQ), (bf16_t*)(ws + WS_Z)};
        pg8::gemm_phase<EpiGU, pg8::StaticOrder>(lds, g, S, E);
    }
    SEAM(7);
    if (IN(8)) {
        pg8::Gemm g{(const bf16_t*)(ws + WS_Z), (const bf16_t*)(ws + WS_WDN), M, DM, DFF, DFF, DFF}; pg8::StaticOrder S; S.init(M, DM, G, (int)blockIdx.x);
        EpiDown E{(const bf16_t*)(ws + WS_B), P.out};
        pg8::gemm_phase<EpiDown, pg8::StaticOrder>(lds, g, S, E);
    }
#undef IN
#undef SEAM
}

extern "C" void kernel_launch(void* const* d_in, const int* in_sizes, int n_in, void* d_out, int out_size, void* d_ws, size_t ws_size, hipStream_t stream) {
    static int grid = 0;
    if (grid == 0) {
        if (n_in != 14 || in_sizes[0] != M * DM || out_size != M * DM || ws_size < WS_END) { fprintf(stderr, "kernel_launch: unexpected shapes (n_in %d, ws %zu)\n", n_in, ws_size); grid = -1; return; }
        int dev = 0, cus = 0, per_cu = 0;
        (void)hipGetDevice(&dev); (void)hipDeviceGetAttribute(&cus, hipDeviceAttributeMultiprocessorCount, dev);
        (void)hipFuncSetAttribute((const void*)fwd_megakernel, hipFuncAttributeMaxDynamicSharedMemorySize, LDS_BYTES);
        (void)hipOccupancyMaxActiveBlocksPerMultiprocessor(&per_cu, (const void*)fwd_megakernel, 512, LDS_BYTES);
        if (per_cu < 1) per_cu = 1;
        grid = cus * per_cu; (void)hipGetLastError();
    }
    if (grid < 0) return;
    Params p{};
    p.x = (const float*)d_in[0]; p.g_mix = (const float*)d_in[1]; p.w_in = (const float*)d_in[2]; p.b_forget = (const float*)d_in[3]; p.g_ret_norm = (const float*)d_in[4];
    p.w_ret_o = (const float*)d_in[5]; p.g_fox_q = (const float*)d_in[6]; p.g_fox_k = (const float*)d_in[7]; p.w_fox_o = (const float*)d_in[8]; p.w_out = (const float*)d_in[9];
    p.g_ffn = (const float*)d_in[10]; p.w_gate = (const float*)d_in[11]; p.w_up = (const float*)d_in[12]; p.w_down = (const float*)d_in[13];
    p.out = (float*)d_out; p.ws = (unsigned char*)d_ws;
#if MK_N_LAUNCHES == 1
    p.ph_lo = 0; p.ph_hi = NPHASE;
    void* args[] = {&p};
    hipError_t e = hipLaunchCooperativeKernel((const void*)fwd_megakernel, dim3(grid), dim3(512), args, LDS_BYTES, stream);
    if (e != hipSuccess) fprintf(stderr, "cooperative launch failed: %s (grid %d)\n", hipGetErrorString(e), grid);
#else
    for (int k = 0; k < NPHASE; ++k) { p.ph_lo = k; p.ph_hi = k + 1; hipLaunchKernelGGL(fwd_megakernel, dim3(grid), dim3(512), LDS_BYTES, stream, p); }
#endif
}
```

```cpp
#include <hip/hip_runtime.h>
#include <hip/hip_cooperative_groups.h>
#include <cstdio>
#include <cstdint>
namespace cg = cooperative_groups;

#ifndef MK_N_LAUNCHES
#define MK_N_LAUNCHES 1
#endif

#define LAS __attribute__((address_space(3)))
typedef unsigned short bf16_t;
typedef short bf16x8 __attribute__((ext_vector_type(8)));
typedef short s16x4 __attribute__((ext_vector_type(4)));
typedef float f32x4 __attribute__((ext_vector_type(4)));
typedef float f32x2 __attribute__((ext_vector_type(2)));
typedef float f32x16 __attribute__((ext_vector_type(16)));
typedef unsigned u32x4 __attribute__((ext_vector_type(4)));
typedef unsigned u32x2 __attribute__((ext_vector_type(2)));

constexpr int M = 65536, DM = 1024, SEQ = 8192, NBATCH = 8;
constexpr int ZP = 5120;
constexpr int QR_OFF = 0, KR_OFF = 256, VR_OFF = 512, GR_OFF = 1024, QF_OFF = 1536, KF_OFF = 2048, VF_OFF = 2560, AR_OFF = 3072, AF_OFF = 4096;
constexpr int INC = 5128;
constexpr int DFF = 2816;
constexpr float EPS = 1e-6f;
constexpr float LOG2E = 1.4426950408889634f;
constexpr float C2 = 0.125f * LOG2E;

constexpr size_t MiB = 1u << 20;
constexpr size_t WS_WIN = 0, WS_WCAT = 10 * MiB, WS_WOUT = 12 * MiB, WS_WGU = 14 * MiB, WS_WDN = 25 * MiB;
constexpr size_t WS_ROPE = 31 * MiB, WS_LOGF = 33 * MiB, WS_C2 = 35 * MiB, WS_SSQ = 37 * MiB, WS_CTL = 41 * MiB, CTL_BYTES = 16384;
constexpr size_t WS_Z = 48 * MiB;
constexpr size_t WS_A = 688 * MiB;
constexpr size_t WS_B = 816 * MiB;
constexpr size_t WS_END = 944 * MiB;
constexpr int LDS_BYTES = 147456, LDS_MISC = LDS_BYTES - 64;

__device__ __forceinline__ unsigned cvtpk(float lo, float hi) { typedef __bf16 b2 __attribute__((ext_vector_type(2))); f32x2 v = {lo, hi}; b2 b = __builtin_convertvector(v, b2); return __builtin_bit_cast(unsigned, b); }
__device__ __forceinline__ float bflo(unsigned w) { return __uint_as_float(w << 16); }
__device__ __forceinline__ float bfhi(unsigned w) { return __uint_as_float(w & 0xffff0000u); }
__device__ __forceinline__ float wave_sum(float v) {
#pragma unroll
    for (int o = 1; o < 64; o <<= 1) v += __shfl_xor(v, o);
    return v;
}
__device__ __forceinline__ float sigmoidf_(float v) { return __builtin_amdgcn_rcpf(1.f + __builtin_amdgcn_exp2f(-v * LOG2E)); }
__device__ __forceinline__ int crow(int r, int hi) { return (r & 3) + 8 * (r >> 2) + 4 * hi; }
#define MFMA32(a, b, c) __builtin_amdgcn_mfma_f32_32x32x16_bf16((a), (b), (c), 0, 0, 0)
typedef short v4i16_t __attribute__((ext_vector_type(4)));
__device__ __forceinline__ s16x4 vtr(const LAS unsigned char* p) { return __builtin_bit_cast(s16x4, __builtin_amdgcn_ds_read_tr16_b64_v4i16((LAS v4i16_t*)p)); }
__device__ __forceinline__ bf16x8 cat8(s16x4 lo, s16x4 hi) { return (bf16x8){lo[0], lo[1], lo[2], lo[3], hi[0], hi[1], hi[2], hi[3]}; }
__device__ __forceinline__ bf16x8 pack8(const f32x16& x, int b) {
    u32x4 p; p[0] = cvtpk(x[b], x[b + 1]); p[1] = cvtpk(x[b + 2], x[b + 3]); p[2] = cvtpk(x[b + 4], x[b + 5]); p[3] = cvtpk(x[b + 6], x[b + 7]);
    return __builtin_bit_cast(bf16x8, p);
}

namespace pg8 {
constexpr int BM = 256, BK = 64, HALF = 128, HTB = HALF * BK * 2, STAGE_BYTES = 8 * HTB, NXCD = 8, WGM = 8;
__host__ __device__ __forceinline__ int lds_byte(int r, int c) { const int st = (r >> 4) * 2 + (c >> 5), rr = r & 15, cc = c & 31, ob = rr * 64 + cc * 2; return st * 1024 + (ob ^ (((ob >> 9) & 1) << 5)); }
__host__ __device__ __forceinline__ void stage_rc(int b, int& R, int& C) { const int st = b / 1024, sb = b % 1024, swz = sb ^ (((sb >> 9) & 1) << 5); R = (st >> 1) * 16 + swz / 64; C = (st & 1) * 32 + (swz % 64) / 2; }
__host__ __device__ __forceinline__ int perm32(int rho) { const int n = rho >> 4, i = rho & 15; return 8 * (i >> 2) + 4 * n + (i & 3); }
struct Unit { int pm, pn, kq, fin; };
struct Gemm { const bf16_t* A; const bf16_t* Bt; int M, N, K, lda, ldb; };
struct StaticOrder {
    int nM, nN, nwg, G, c;
    __device__ void init(int M_, int N_, int G_, int c_) { nM = M_ / BM; nN = N_ / BM; nwg = nM * nN; G = G_; c = c_; }
    __device__ bool next(int i, Unit& u) const {
        const long L = (long)i * G + c; if (L >= nwg) return false;
        int wgid = (int)L; { const int q = nwg / NXCD, r = nwg % NXCD, xcd = wgid % NXCD, off = wgid / NXCD; wgid = (xcd < r ? xcd * (q + 1) : r * (q + 1) + (xcd - r) * q) + off; }
        const int nig = WGM * nN, gid = wgid / nig, fm = gid * WGM, gsz = (nM - fm) < WGM ? (nM - fm) : WGM;
        u.pm = fm + ((wgid % nig) % gsz); u.pn = (wgid % nig) / gsz; u.kq = 0; u.fin = 1; return true;
    }
};
struct PairOrder {
    StaticOrder base; int khalf;
    __device__ bool next(int i, Unit& u) const { if (!base.next(i >> 1, u)) return false; u.kq = (i & 1) * khalf; u.fin = i & 1; return true; }
};
template <class Epi, class Sched>
__device__ __forceinline__ void gemm_phase(LAS unsigned char* lds, const Gemm g, const Sched& S, const Epi& E) {
    const int tid = threadIdx.x, wid = __builtin_amdgcn_readfirstlane(tid >> 6), lane = tid & 63, wr = wid >> 2, wc = wid & 3, fr = lane & 15, fq = lane >> 4;
    const int K = g.K, nt = K / BK;
    unsigned voffA[2], voffB[2];
#pragma unroll
    for (int i = 0; i < 2; ++i) { int R, C; stage_rc(tid * 16 + i * 8192, R, C); const int Rb = Epi::PERM ? ((R & ~31) + perm32(R & 31)) : R;
        voffA[i] = (unsigned)(R * g.lda + C) * 2u; voffB[i] = (unsigned)(Rb * g.ldb + C) * 2u; }
    const size_t kstep = (size_t)(BK * 2);
    const size_t hstepA = (size_t)HALF * g.lda * 2, tstepA = 2 * hstepA, hstepB = (size_t)HALF * g.ldb * 2, tstepB = 2 * hstepB;
    const unsigned ldsw = (unsigned)wid * 1024u;
    const int aoff = lds_byte(wr * 64 + fr, fq * 8), boff = lds_byte(wc * 32 + fr, fq * 8);
#define PG8_SA(b, h) (((b) * 2 + (h)) * HTB)
#define PG8_SB(b, h) ((4 + (b) * 2 + (h)) * HTB)
#define PG8_STAGE(bufoff, gbase, voff) do { _Pragma("unroll") for (int _i = 0; _i < 2; ++_i) \
        __builtin_amdgcn_global_load_lds((const unsigned*)((const char*)(gbase) + (voff)[_i]), (LAS unsigned*)(lds + (bufoff) + ldsw + _i * 8192), 16, 0, 0); } while (0)
#define PG8_LDA(dst, b, h) do { _Pragma("unroll") for (int m = 0; m < 4; ++m) _Pragma("unroll") for (int k = 0; k < 2; ++k) dst[m][k] = *(const LAS bf16x8*)(lds + PG8_SA(b, h) + aoff + m * 2048 + k * 1024); } while (0)
#define PG8_LDB(dst, b, h) do { _Pragma("unroll") for (int n = 0; n < 2; ++n) _Pragma("unroll") for (int k = 0; k < 2; ++k) dst[n][k] = *(const LAS bf16x8*)(lds + PG8_SB(b, h) + boff + n * 2048 + k * 1024); } while (0)
#define PG8_MMA(ai, bj, At, Bt) do { __builtin_amdgcn_s_setprio(1); _Pragma("unroll") for (int m = 0; m < 4; ++m) _Pragma("unroll") for (int n = 0; n < 2; ++n) _Pragma("unroll") for (int k = 0; k < 2; ++k) \
        acc[ai][bj][m][n] = __builtin_amdgcn_mfma_f32_16x16x32_bf16(Bt[n][k], At[m][k], acc[ai][bj][m][n], 0, 0, 0); __builtin_amdgcn_s_setprio(0); } while (0)
#define PG8_WAIT_V(n) asm volatile("s_waitcnt vmcnt(" #n ")" ::: "memory")
#define PG8_WAIT_L(n) asm volatile("s_waitcnt lgkmcnt(" #n ")" ::: "memory")
#define PG8_BAR __builtin_amdgcn_s_barrier()
#define PG8_SCHED __builtin_amdgcn_sched_barrier(0)
    Unit cur, nxt; int ui = 0;
    if (!S.next(0, cur)) return;
    f32x4 acc[2][2][4][2];
#pragma unroll
    for (int a = 0; a < 2; ++a)
#pragma unroll
        for (int b = 0; b < 2; ++b)
#pragma unroll
            for (int m = 0; m < 4; ++m)
#pragma unroll
                for (int n = 0; n < 2; ++n) acc[a][b][m][n] = (f32x4){0.f, 0.f, 0.f, 0.f};
    bf16x8 At[4][2], B0[2][2], B1[2][2];
    const char* cA = (const char*)g.A + (size_t)cur.pm * tstepA + (size_t)cur.kq * 2; const char* cB = (const char*)g.Bt + (size_t)cur.pn * tstepB + (size_t)cur.kq * 2;
    PG8_STAGE(PG8_SB(0, 0), cB, voffB); PG8_STAGE(PG8_SB(0, 1), cB + hstepB, voffB); PG8_STAGE(PG8_SA(0, 0), cA, voffA); PG8_STAGE(PG8_SA(0, 1), cA + hstepA, voffA);
    if (wr == 1) PG8_BAR;
    PG8_WAIT_V(2); PG8_BAR;
    PG8_STAGE(PG8_SB(1, 0), cB + kstep, voffB); PG8_STAGE(PG8_SA(1, 0), cA + kstep, voffA); PG8_STAGE(PG8_SB(1, 1), cB + hstepB + kstep, voffB);
    PG8_WAIT_V(6); PG8_BAR;
    for (;;) {
        const bool has_next = S.next(ui + 1, nxt);
        const char* nA = has_next ? (const char*)g.A + (size_t)nxt.pm * tstepA + (size_t)nxt.kq * 2 : cA; const char* nB = has_next ? (const char*)g.Bt + (size_t)nxt.pn * tstepB + (size_t)nxt.kq * 2 : cB;
        for (int t = 0; t < nt; t += 2) {
            const bool last = (t == nt - 2);
            const char* a1 = cA + (size_t)(t + 1) * kstep;
            const char* a2 = last ? nA : cA + (size_t)(t + 2) * kstep; const char* b2 = last ? nB : cB + (size_t)(t + 2) * kstep;
            const char* a3 = a2 + kstep; const char* b3 = b2 + kstep;
            PG8_LDB(B0, 0, 0); PG8_LDB(B1, 0, 1); PG8_SCHED; PG8_LDA(At, 0, 0); PG8_STAGE(PG8_SA(1, 1), a1 + hstepA, voffA);
            PG8_WAIT_V(8); PG8_WAIT_L(0); PG8_BAR; PG8_MMA(0, 0, At, B0); PG8_MMA(0, 1, At, B1); PG8_BAR; PG8_SCHED;
            PG8_LDA(At, 0, 1); PG8_STAGE(PG8_SB(0, 0), b2, voffB); PG8_STAGE(PG8_SB(0, 1), b2 + hstepB, voffB); PG8_STAGE(PG8_SA(0, 0), a2, voffA);
            PG8_WAIT_V(8); PG8_WAIT_L(0); PG8_BAR; PG8_MMA(1, 0, At, B0); PG8_MMA(1, 1, At, B1); PG8_BAR; PG8_SCHED;
            PG8_LDB(B0, 1, 0); PG8_LDB(B1, 1, 1); PG8_SCHED; PG8_LDA(At, 1, 0); PG8_STAGE(PG8_SA(0, 1), a2 + hstepA, voffA);
            PG8_WAIT_V(8); PG8_WAIT_L(0); PG8_BAR; PG8_MMA(0, 0, At, B0); PG8_MMA(0, 1, At, B1); PG8_BAR; PG8_SCHED;
            PG8_LDA(At, 1, 1); PG8_STAGE(PG8_SB(1, 0), b3, voffB); PG8_STAGE(PG8_SB(1, 1), b3 + hstepB, voffB); PG8_STAGE(PG8_SA(1, 0), a3, voffA);
            PG8_WAIT_V(8); PG8_WAIT_L(0); PG8_BAR; PG8_MMA(1, 0, At, B0); PG8_MMA(1, 1, At, B1); PG8_BAR; PG8_SCHED;
        }
        if (wr == 0) PG8_BAR;
        const bool keep = Epi::MID && !cur.fin;
        if (keep) E.mid(acc, cur, wr, wc, fr, fq); else E(acc, cur, wr, wc, fr, fq);
        if (!has_next) break;
        if (!keep)
#pragma unroll
        for (int a = 0; a < 2; ++a)
#pragma unroll
            for (int b = 0; b < 2; ++b)
#pragma unroll
                for (int m = 0; m < 4; ++m)
#pragma unroll
                    for (int n = 0; n < 2; ++n) acc[a][b][m][n] = (f32x4){0.f, 0.f, 0.f, 0.f};
        cur = nxt; cA = nA; cB = nB; ++ui;
        if (wr == 1) PG8_BAR;
    }
    PG8_WAIT_V(0);
    PG8_BAR;
#undef PG8_SA
#undef PG8_SB
#undef PG8_STAGE
#undef PG8_LDA
#undef PG8_LDB
#undef PG8_MMA
#undef PG8_WAIT_V
#undef PG8_WAIT_L
#undef PG8_BAR
#undef PG8_SCHED
}
}
using pg8::Unit;

struct EpiZ {
    static constexpr bool PERM = true, MID = false;
    bf16_t* Z; const float* rope; const float* gq; const float* gk;
    __device__ __forceinline__ void mid(f32x4 (&)[2][2][4][2], const Unit&, int, int, int, int) const {}
    __device__ __forceinline__ void operator()(const f32x4 (&acc)[2][2][4][2], const Unit& u, int wr, int wc, int fr, int fq) const {
        const int T = u.pn; const int row0 = u.pm * 256 + wr * 64 + fr; const int colp = wc * 32 + 8 * fq;
        if (T < 2) {
            const int i4 = 4 * (wc & 1) + fq;
            float lg[2];
#pragma unroll
            for (int bj = 0; bj < 2; ++bj) { const int head = 2 * bj + (wc >> 1); lg[bj] = log2f(1.f - exp2f(-5.f - (float)head)); }
#pragma unroll
            for (int ai = 0; ai < 2; ++ai)
#pragma unroll
                for (int m = 0; m < 4; ++m) {
                    const int row = row0 + ai * 128 + m * 16; const int t = row & (SEQ - 1); const float il = (float)(row & 127);
                    const f32x4* rp = (const f32x4*)(rope + ((size_t)t * 32 + 4 * i4) * 2); const f32x4 c0 = rp[0], c1 = rp[1];
                    const float cs[4] = {c0[0], c0[2], c1[0], c1[2]}, sn[4] = {c0[1], c0[3], c1[1], c1[3]};
#pragma unroll
                    for (int bj = 0; bj < 2; ++bj) {
                        const f32x4 x1 = acc[ai][bj][m][0], x2 = acc[ai][bj][m][1];
                        const float sc = (T == 0) ? exp2f(il * lg[bj]) : 0.125f * exp2f(-il * lg[bj]);
                        float y1[4], y2[4];
#pragma unroll
                        for (int k = 0; k < 4; ++k) { y1[k] = (x1[k] * cs[k] - x2[k] * sn[k]) * sc; y2[k] = (x1[k] * sn[k] + x2[k] * cs[k]) * sc; }
                        u32x4 w; w[0] = cvtpk(y1[0], y1[1]); w[1] = cvtpk(y1[2], y1[3]); w[2] = cvtpk(y2[0], y2[1]); w[3] = cvtpk(y2[2], y2[3]);
                        *(u32x4*)(Z + (size_t)row * ZP + 256 * T + 128 * bj + colp) = w;
                    }
                }
        } else if (T >= 6 && T < 10) {
            const bool isq = T < 8; const float* g = isq ? gq : gk; const float sc = isq ? C2 : 1.f;
            f32x4 gv[2][2];
#pragma unroll
            for (int bj = 0; bj < 2; ++bj)
#pragma unroll
                for (int n = 0; n < 2; ++n) gv[bj][n] = *(const f32x4*)(g + 32 * bj + 8 * fq + 4 * n);
#pragma unroll
            for (int ai = 0; ai < 2; ++ai)
#pragma unroll
                for (int m = 0; m < 4; ++m) {
                    const int row = row0 + ai * 128 + m * 16; float ss = 0.f;
#pragma unroll
                    for (int bj = 0; bj < 2; ++bj)
#pragma unroll
                        for (int n = 0; n < 2; ++n) { const f32x4 v = acc[ai][bj][m][n]; ss += (v[0] * v[0] + v[1] * v[1]) + (v[2] * v[2] + v[3] * v[3]); }
                    ss += __shfl_xor(ss, 16); ss += __shfl_xor(ss, 32);
                    const float rs = rsqrtf(ss * (1.f / 64.f) + EPS) * sc;
#pragma unroll
                    for (int bj = 0; bj < 2; ++bj) {
                        const f32x4 v0 = acc[ai][bj][m][0] * rs * gv[bj][0], v1 = acc[ai][bj][m][1] * rs * gv[bj][1];
                        u32x4 w; w[0] = cvtpk(v0[0], v0[1]); w[1] = cvtpk(v0[2], v0[3]); w[2] = cvtpk(v1[0], v1[1]); w[3] = cvtpk(v1[2], v1[3]);
                        *(u32x4*)(Z + (size_t)row * ZP + 256 * T + 64 * wc + 32 * bj + 8 * fq) = w;
                    }
                }
        } else if (T >= 12) {
            const int cg_ = 128 * (T - 12) + colp;
#pragma unroll
            for (int ai = 0; ai < 2; ++ai)
#pragma unroll
                for (int m = 0; m < 4; ++m) {
                    const int row = row0 + ai * 128 + m * 16; float rt[8], sf[8];
#pragma unroll
                    for (int n = 0; n < 2; ++n)
#pragma unroll
                        for (int k = 0; k < 4; ++k) { const float er = __builtin_amdgcn_exp2f(-acc[ai][0][m][n][k] * LOG2E), ef = __builtin_amdgcn_exp2f(-fmaxf(acc[ai][1][m][n][k], -60.f) * LOG2E);
                            rt[4 * n + k] = (1.f + ef) * __builtin_amdgcn_rcpf(1.f + er); sf[4 * n + k] = __builtin_amdgcn_rcpf(1.f + ef); }
                    u32x4 w; w[0] = cvtpk(rt[0], rt[1]); w[1] = cvtpk(rt[2], rt[3]); w[2] = cvtpk(rt[4], rt[5]); w[3] = cvtpk(rt[6], rt[7]);
                    *(u32x4*)(Z + (size_t)row * ZP + AR_OFF + cg_) = w;
                    w[0] = cvtpk(sf[0], sf[1]); w[1] = cvtpk(sf[2], sf[3]); w[2] = cvtpk(sf[4], sf[5]); w[3] = cvtpk(sf[6], sf[7]);
                    *(u32x4*)(Z + (size_t)row * ZP + AF_OFF + cg_) = w;
                }
        } else {
            const int mode = (T == 4 || T == 5) ? 1 : 0;
#pragma unroll
            for (int ai = 0; ai < 2; ++ai)
#pragma unroll
                for (int m = 0; m < 4; ++m) {
                    const int row = row0 + ai * 128 + m * 16;
#pragma unroll
                    for (int bj = 0; bj < 2; ++bj) {
                        f32x4 v0 = acc[ai][bj][m][0], v1 = acc[ai][bj][m][1];
                        if (mode) {
#pragma unroll
                            for (int k = 0; k < 4; ++k) { const float s0 = sigmoidf_(v0[k]), s1 = sigmoidf_(v1[k]); v0[k] = (mode == 1) ? v0[k] * s0 : s0; v1[k] = (mode == 1) ? v1[k] * s1 : s1; }
                        }
                        u32x4 w; w[0] = cvtpk(v0[0], v0[1]); w[1] = cvtpk(v0[2], v0[3]); w[2] = cvtpk(v1[0], v1[1]); w[3] = cvtpk(v1[2], v1[3]);
                        *(u32x4*)(Z + (size_t)row * ZP + 256 * T + 128 * bj + colp) = w;
                    }
                }
        }
    }
};
struct EpiMerge {
    static constexpr bool PERM = true, MID = true;
    const bf16_t* Z; bf16_t* MG;
    __device__ __forceinline__ void mid(f32x4 (&acc)[2][2][4][2], const Unit& u, int wr, int wc, int fr, int fq) const {
        const int row0 = u.pm * 256 + wr * 64 + fr; const int col0 = u.pn * 256 + wc * 32 + 8 * fq;
#pragma unroll
        for (int ai = 0; ai < 2; ++ai)
#pragma unroll
            for (int m = 0; m < 4; ++m)
#pragma unroll
                for (int bj = 0; bj < 2; ++bj) {
                    const bf16_t* zp = Z + (size_t)(row0 + ai * 128 + m * 16) * ZP + col0 + 128 * bj;
                    const u32x4 a = *(const u32x4*)(zp + AR_OFF);
#pragma unroll
                    for (int k = 0; k < 2; ++k) {
                        acc[ai][bj][m][0][2 * k] *= bflo(a[k]); acc[ai][bj][m][0][2 * k + 1] *= bfhi(a[k]);
                        acc[ai][bj][m][1][2 * k] *= bflo(a[2 + k]); acc[ai][bj][m][1][2 * k + 1] *= bfhi(a[2 + k]);
                    }
                }
    }
    __device__ __forceinline__ void operator()(const f32x4 (&acc)[2][2][4][2], const Unit& u, int wr, int wc, int fr, int fq) const {
        const int row0 = u.pm * 256 + wr * 64 + fr; const int col0 = u.pn * 256 + wc * 32 + 8 * fq;
#pragma unroll
        for (int ai = 0; ai < 2; ++ai)
#pragma unroll
            for (int m = 0; m < 4; ++m)
#pragma unroll
                for (int bj = 0; bj < 2; ++bj) {
                    const int row = row0 + ai * 128 + m * 16;
                    const u32x4 f = *(const u32x4*)(Z + (size_t)row * ZP + col0 + 128 * bj + AF_OFF);
                    const f32x4 v0 = acc[ai][bj][m][0], v1 = acc[ai][bj][m][1];
                    u32x4 w; w[0] = cvtpk(v0[0] * bflo(f[0]), v0[1] * bfhi(f[0])); w[1] = cvtpk(v0[2] * bflo(f[1]), v0[3] * bfhi(f[1]));
                    w[2] = cvtpk(v1[0] * bflo(f[2]), v1[1] * bfhi(f[2])); w[3] = cvtpk(v1[2] * bflo(f[3]), v1[3] * bfhi(f[3]));
                    *(u32x4*)(MG + (size_t)row * DM + col0 + 128 * bj) = w;
                }
    }
};
struct EpiOut {
    static constexpr bool PERM = false, MID = false;
    const float* x; bf16_t* X1B; float* SSQ;
    __device__ __forceinline__ void mid(f32x4 (&)[2][2][4][2], const Unit&, int, int, int, int) const {}
    __device__ __forceinline__ void operator()(const f32x4 (&acc)[2][2][4][2], const Unit& u, int wr, int wc, int fr, int fq) const {
        const int row0 = u.pm * 256 + wr * 64 + fr; const int col0 = u.pn * 256 + wc * 32 + 4 * fq;
#pragma unroll
        for (int ai = 0; ai < 2; ++ai)
#pragma unroll
            for (int m = 0; m < 4; ++m) {
                const int row = row0 + ai * 128 + m * 16; const size_t off = (size_t)row * DM + col0; float ss = 0.f;
#pragma unroll
                for (int bj = 0; bj < 2; ++bj)
#pragma unroll
                    for (int n = 0; n < 2; ++n) {
                        const f32x4 v = *(const f32x4*)(x + off + bj * 128 + n * 16) + acc[ai][bj][m][n];
                        u32x2 w; w[0] = cvtpk(v[0], v[1]); w[1] = cvtpk(v[2], v[3]); *(u32x2*)(X1B + off + bj * 128 + n * 16) = w;
                        ss += (v[0] * v[0] + v[1] * v[1]) + (v[2] * v[2] + v[3] * v[3]);
                    }
                ss += __shfl_xor(ss, 16); ss += __shfl_xor(ss, 32);
                if (fq == 0) SSQ[(size_t)row * 16 + u.pn * 4 + wc] = ss;
            }
    }
};
struct EpiGU {
    static constexpr bool PERM = true, MID = false;
    const float* SSQ; bf16_t* HID;
    __device__ __forceinline__ void mid(f32x4 (&)[2][2][4][2], const Unit&, int, int, int, int) const {}
    __device__ __forceinline__ void operator()(const f32x4 (&acc)[2][2][4][2], const Unit& u, int wr, int wc, int fr, int fq) const {
        const int row0 = u.pm * 256 + wr * 64 + fr; const int col0 = u.pn * 128 + wc * 32 + 8 * fq;
#pragma unroll
        for (int ai = 0; ai < 2; ++ai)
#pragma unroll
            for (int m = 0; m < 4; ++m) {
                const int row = row0 + ai * 128 + m * 16;
                const f32x4* sp = (const f32x4*)(SSQ + (size_t)row * 16); const f32x4 s0 = sp[0], s1 = sp[1], s2 = sp[2], s3 = sp[3];
                const float ss = (((s0[0] + s0[1]) + (s0[2] + s0[3])) + ((s1[0] + s1[1]) + (s1[2] + s1[3]))) + (((s2[0] + s2[1]) + (s2[2] + s2[3])) + ((s3[0] + s3[1]) + (s3[2] + s3[3])));
                const float rs = rsqrtf(ss * (1.f / 1024.f) + EPS);
                float hv[8];
#pragma unroll
                for (int n = 0; n < 2; ++n)
#pragma unroll
                    for (int k = 0; k < 4; ++k) { const float gte = acc[ai][0][m][n][k] * rs, up = acc[ai][1][m][n][k] * rs; hv[4 * n + k] = gte * sigmoidf_(gte) * up; }
                u32x4 w; w[0] = cvtpk(hv[0], hv[1]); w[1] = cvtpk(hv[2], hv[3]); w[2] = cvtpk(hv[4], hv[5]); w[3] = cvtpk(hv[6], hv[7]);
                *(u32x4*)(HID + (size_t)row * DFF + col0) = w;
            }
    }
};
struct EpiDown {
    static constexpr bool PERM = false, MID = false;
    const bf16_t* X1B; float* out;
    __device__ __forceinline__ void mid(f32x4 (&)[2][2][4][2], const Unit&, int, int, int, int) const {}
    __device__ __forceinline__ void operator()(const f32x4 (&acc)[2][2][4][2], const Unit& u, int wr, int wc, int fr, int fq) const {
        const int row0 = u.pm * 256 + wr * 64 + fr; const int col0 = u.pn * 256 + wc * 32 + 4 * fq;
#pragma unroll
        for (int ai = 0; ai < 2; ++ai)
#pragma unroll
            for (int m = 0; m < 4; ++m) {
                const size_t off = (size_t)(row0 + ai * 128 + m * 16) * DM + col0;
#pragma unroll
                for (int bj = 0; bj < 2; ++bj)
#pragma unroll
                    for (int n = 0; n < 2; ++n) { const u32x2 xb = *(const u32x2*)(X1B + off + bj * 128 + n * 16); const f32x4 xr = {bflo(xb[0]), bfhi(xb[0]), bflo(xb[1]), bfhi(xb[1])};
                        *(f32x4*)(out + off + bj * 128 + n * 16) = xr + acc[ai][bj][m][n]; }
            }
    }
};

struct Params {
    const float *x, *g_mix, *w_in, *b_forget, *g_ret_norm, *w_ret_o, *g_fox_q, *g_fox_k, *w_fox_o, *w_out, *g_ffn, *w_gate, *w_up, *w_down;
    float* out; unsigned char* ws; int ph_lo, ph_hi;
};

__device__ __forceinline__ int win_src(int np) {
    const int T = np >> 8, p = np & 255;
    if (T < 2) { const int head = p >> 6, w = p & 63, i = w >> 3, j = w & 7; const int d = (j < 4) ? (4 * i + j) : (32 + 4 * i + (j - 4)); return T * 256 + head * 64 + d; }
    if (T >= 6 && T < 10) { const int hit = (p & 127) >> 5, d = 32 * (p >> 7) + (p & 31); return 256 * T + hit * 64 + d; }
    if (T >= 12) { const int c = 128 * (T - 12) + (p & 127); return ((p >> 7) ? 4104 : 3080) + c; }
    return np;
}
struct TDesc { const float* src; const float* kscale; bf16_t* dst; int pitch, ldt, k0; };
__device__ __forceinline__ TDesc tile_desc(const Params& P, int it) {
    const int tid = threadIdx.x, nn = tid & 63;
    unsigned char* ws = P.ws;
    constexpr int T0 = 80 * 16, T1 = 16 * 8, T2 = 16 * 8, T3 = 16 * 16, T4 = 88 * 16;
    const float* W; int pitch, srccol, ldt, n0, k0, koff = 0; const float* ksc = nullptr; bf16_t* WT; int r = it;
    if (r < T0) { const int tn = r / 16, tk = r % 16; W = P.w_in; pitch = INC; srccol = win_src(tn * 64 + nn); WT = (bf16_t*)(ws + WS_WIN); ldt = 1024; n0 = tn * 64; k0 = tk * 64; }
    else if ((r -= T0) < T1) { const int tn = r / 8, tk = r % 8; W = P.w_ret_o; pitch = 1024; srccol = tn * 64 + nn; WT = (bf16_t*)(ws + WS_WCAT); ldt = 1024; n0 = tn * 64; k0 = tk * 64; }
    else if ((r -= T1) < T2) { const int tn = r / 8, tk = r % 8; W = P.w_fox_o; pitch = 1024; srccol = tn * 64 + nn; WT = (bf16_t*)(ws + WS_WCAT); ldt = 1024; n0 = tn * 64; k0 = tk * 64; koff = 512; }
    else if ((r -= T2) < T3) { const int tn = r / 16, tk = r % 16; W = P.w_out; pitch = 1024; srccol = tn * 64 + nn; WT = (bf16_t*)(ws + WS_WOUT); ldt = 1024; n0 = tn * 64; k0 = tk * 64; }
    else if ((r -= T3) < T4) { const int tn = r / 16, tk = r % 16; n0 = tn * 64; const int T = n0 >> 8, p = n0 & 255; W = (p >= 128) ? P.w_up : P.w_gate; pitch = DFF; srccol = 128 * T + (p & 127) + nn;
                               ksc = P.g_ffn; WT = (bf16_t*)(ws + WS_WGU); ldt = 1024; k0 = tk * 64; }
    else { r -= T4; const int tn = r / 44, tk = r % 44; W = P.w_down; pitch = 1024; srccol = tn * 64 + nn; WT = (bf16_t*)(ws + WS_WDN); ldt = DFF; n0 = tn * 64; k0 = tk * 64; }
    TDesc d; d.src = W + (size_t)(k0 + (tid >> 6)) * pitch + srccol; d.kscale = ksc; d.pitch = pitch; d.ldt = ldt; d.k0 = k0;
    d.dst = WT + (size_t)(n0 + (tid >> 3)) * ldt + koff + k0 + 8 * (tid & 7);
    return d;
}
__device__ __forceinline__ void p0_prologue(const Params& P, LAS unsigned char* lds) {
    const int tid = threadIdx.x, lane = tid & 63, wave = tid >> 6, G = gridDim.x;
    unsigned char* ws = P.ws;
    LAS float* scr = (LAS float*)lds;
    constexpr int NT = 80 * 16 + 16 * 8 + 16 * 8 + 16 * 16 + 88 * 16 + 16 * 44;
    {
        float cur[8], nxt[8]; TDesc dc, dn;
        int it = blockIdx.x;
        if (it < NT) { dc = tile_desc(P, it);
#pragma unroll
            for (int ps = 0; ps < 8; ++ps) cur[ps] = dc.src[(size_t)(8 * ps) * dc.pitch]; }
        for (; it < NT; it += G) {
            const bool hn = it + G < NT;
            if (hn) { dn = tile_desc(P, it + G);
#pragma unroll
                for (int ps = 0; ps < 8; ++ps) nxt[ps] = dn.src[(size_t)(8 * ps) * dn.pitch]; }
            { const int nn = tid & 63, kk0 = tid >> 6;
#pragma unroll
              for (int ps = 0; ps < 8; ++ps) scr[(kk0 + 8 * ps) * 65 + nn] = cur[ps]; }
            __syncthreads();
            { const int nn = tid >> 3, c = tid & 7; float v[8];
#pragma unroll
              for (int j = 0; j < 8; ++j) { v[j] = scr[(8 * c + j) * 65 + nn]; if (dc.kscale) v[j] *= dc.kscale[dc.k0 + 8 * c + j]; }
              u32x4 o; o[0] = cvtpk(v[0], v[1]); o[1] = cvtpk(v[2], v[3]); o[2] = cvtpk(v[4], v[5]); o[3] = cvtpk(v[6], v[7]);
              *(u32x4*)dc.dst = o; }
            __syncthreads();
            if (hn) { dc = dn;
#pragma unroll
                for (int ps = 0; ps < 8; ++ps) cur[ps] = nxt[ps]; }
        }
    }
    { float* rope = (float*)(ws + WS_ROPE);
      for (int i = blockIdx.x * 512 + tid; i < SEQ * 32; i += G * 512) {
          const int t = i >> 5, d = i & 31;
          const float inv_freq = 1.0f / exp2f((float)d * (13.287712379549449f / 32.f));
          const float ang = (float)t * inv_freq;
          const double ad = (double)ang; const double nrev = __builtin_rint(ad * 0.15915494309189535); const float rr = (float)(ad - nrev * 6.283185307179586);
          rope[2 * i] = cosf(rr); rope[2 * i + 1] = sinf(rr);
      } }
    LAS float* wf = (LAS float*)(lds + 32768);
    for (int i = tid; i < 8192; i += 512) { const int col = i >> 3; wf[(col >> 2) * 36 + (col & 3) * 8 + (i & 7)] = P.w_in[(size_t)col * INC + 3072 + (i & 7)]; }
    __syncthreads();
    bf16_t* XN = (bf16_t*)(ws + WS_A); float* LOGF = (float*)(ws + WS_LOGF);
    const int gw = blockIdx.x * 8 + wave, NGW = G * 8;
    f32x4 nv[4];
    if (gw < M) {
#pragma unroll
        for (int j = 0; j < 4; ++j) nv[j] = ((const f32x4*)(P.x + (size_t)gw * DM) + lane)[64 * j]; }
    for (int m = gw; m < M; m += NGW) {
        f32x4 v[4]; float ss = 0.f;
#pragma unroll
        for (int j = 0; j < 4; ++j) v[j] = nv[j];
        if (m + NGW < M) {
#pragma unroll
            for (int j = 0; j < 4; ++j) nv[j] = ((const f32x4*)(P.x + (size_t)(m + NGW) * DM) + lane)[64 * j]; }
#pragma unroll
        for (int j = 0; j < 4; ++j) ss += (v[j][0] * v[j][0] + v[j][1] * v[j][1]) + (v[j][2] * v[j][2] + v[j][3] * v[j][3]);
        const float rstd = rsqrtf(wave_sum(ss) * (1.f / DM) + EPS);
        float fa[8];
#pragma unroll
        for (int q = 0; q < 8; ++q) fa[q] = 0.f;
#pragma unroll
        for (int j = 0; j < 4; ++j) {
            const f32x4 gm = ((const f32x4*)P.g_mix)[lane + 64 * j]; v[j] = v[j] * rstd * gm;
            u32x2 w; w[0] = cvtpk(v[j][0], v[j][1]); w[1] = cvtpk(v[j][2], v[j][3]);
            *(u32x2*)(XN + (size_t)m * DM + 4 * lane + 256 * j) = w;
#pragma unroll
            for (int k = 0; k < 4; ++k) { const int wo = (lane + 64 * j) * 36 + k * 8; const f32x4 w0 = *(const LAS f32x4*)(wf + wo), w1 = *(const LAS f32x4*)(wf + wo + 4);
#pragma unroll
                for (int q = 0; q < 4; ++q) { fa[q] += v[j][k] * w0[q]; fa[4 + q] += v[j][k] * w1[q]; } }
        }
#pragma unroll
        for (int q = 0; q < 8; ++q) fa[q] = wave_sum(fa[q]);
        float z = fa[0];
#pragma unroll
        for (int q = 1; q < 8; ++q) z = (lane == q) ? fa[q] : z;
        if (lane < 8) { z += P.b_forget[lane]; const float ls = fminf(z, 0.f) - log1pf(expf(-fabsf(z))); LOGF[(size_t)m * 8 + lane] = ls * LOG2E; }
    }
}

__device__ __forceinline__ void cumsum_c2(const Params& P, LAS unsigned char* lds) {
    const int tid = threadIdx.x, lane = tid & 63, wave = tid >> 6;
    const float* LOGF = (const float*)(P.ws + WS_LOGF); float* Cc = (float*)(P.ws + WS_C2);
    LAS float* wtot = (LAS float*)lds;
    for (int bh = blockIdx.x; bh < 64; bh += gridDim.x) {
        const int b = bh >> 3, h = bh & 7; const float* src = LOGF + ((size_t)b * SEQ + 16 * tid) * 8 + h;
        float v[16]; float s = 0.f;
#pragma unroll
        for (int i = 0; i < 16; ++i) { v[i] = src[i * 8]; }
#pragma unroll
        for (int i = 0; i < 16; ++i) { s += v[i]; v[i] = s; }
        float inc = s;
#pragma unroll
        for (int o = 1; o < 64; o <<= 1) { const float t = __shfl_up(inc, o); if (lane >= o) inc += t; }
        if (lane == 63) wtot[wave] = inc;
        __syncthreads();
        float base = inc - s;
        for (int w2 = 0; w2 < wave; ++w2) base += wtot[w2];
        float* dst = Cc + (size_t)bh * SEQ + 16 * tid;
#pragma unroll
        for (int i = 0; i < 4; ++i) *(f32x4*)(dst + 4 * i) = (f32x4){base + v[4 * i], base + v[4 * i + 1], base + v[4 * i + 2], base + v[4 * i + 3]};
        __syncthreads();
    }
}

constexpr int KS = 144, VS = 272;
__device__ __forceinline__ void ret_kv_phase(const Params& P, LAS unsigned char* lds) {
    const int tid = threadIdx.x, lane = tid & 63, w = __builtin_amdgcn_readfirstlane(tid >> 6), r = lane & 31, h = lane >> 5;
    const int q4 = (lane & 15) >> 2, p4 = lane & 3, g16 = (lane >> 4) & 1;
    const bf16_t* Z = (const bf16_t*)(P.ws + WS_Z); float* KV = (float*)(P.ws + WS_A);
    constexpr int HB = 128 * KS + 128 * VS;
    for (int u = blockIdx.x; u < 1024; u += gridDim.x) {
        const int b = u >> 7, n = (u >> 1) & 63, hp = u & 1; const size_t R0 = (size_t)b * SEQ + (size_t)n * 128;
#pragma unroll
        for (int i = 0; i < 4; ++i) { const int id = tid + 512 * i; const int hh = id >> 10, row = (id >> 3) & 127, ch = id & 7;
            const u32x4 v = *(const u32x4*)(Z + (R0 + row) * ZP + KR_OFF + (2 * hp + hh) * 64 + 8 * ch);
            *(LAS u32x4*)(lds + hh * HB + row * KS + ch * 16) = v; }
#pragma unroll
        for (int i = 0; i < 8; ++i) { const int id = tid + 512 * i; const int hh = id >> 11, row = (id >> 4) & 127, ch = id & 15;
            const u32x4 v = *(const u32x4*)(Z + (R0 + row) * ZP + VR_OFF + (2 * hp + hh) * 128 + 8 * ch);
            *(LAS u32x4*)(lds + hh * HB + 128 * KS + row * VS + ch * 16) = v; }
        __syncthreads();
        const int hh = w >> 2, eb = w & 3, head = 2 * hp + hh;
        const LAS unsigned char* Kt = lds + hh * HB; const LAS unsigned char* Vt = Kt + 128 * KS;
        f32x16 acc[2];
#pragma unroll
        for (int i = 0; i < 16; ++i) { acc[0][i] = 0.f; acc[1][i] = 0.f; }
#pragma unroll
        for (int ks = 0; ks < 8; ++ks) {
            const int jr = 16 * ks + 8 * h + q4;
            const bf16x8 bfv = cat8(vtr(Vt + jr * VS + (32 * eb + 16 * g16 + 4 * p4) * 2), vtr(Vt + (jr + 4) * VS + (32 * eb + 16 * g16 + 4 * p4) * 2));
#pragma unroll
            for (int db = 0; db < 2; ++db) {
                const bf16x8 af = cat8(vtr(Kt + jr * KS + (32 * db + 16 * g16 + 4 * p4) * 2), vtr(Kt + (jr + 4) * KS + (32 * db + 16 * g16 + 4 * p4) * 2));
                acc[db] = MFMA32(af, bfv, acc[db]);
            }
        }
        float* dst = KV + ((size_t)((b * 64 + n) * 4 + head)) * 8192 + 32 * eb + r;
#pragma unroll
        for (int db = 0; db < 2; ++db)
#pragma unroll
            for (int i = 0; i < 16; ++i) dst[(32 * db + crow(i, h)) * 128] = acc[db][i];
        __syncthreads();
    }
}
__device__ __forceinline__ void ret_scan(const Params& P) {
    const float* KV = (const float*)(P.ws + WS_A); bf16_t* ST = (bf16_t*)(P.ws + WS_A + 64 * MiB);
    for (int p = blockIdx.x * 512 + threadIdx.x; p < 131072; p += gridDim.x * 512) {
        const int b = p >> 14, head = (p >> 12) & 3, de = p & 4095;
        const float g = exp2f(128.f * log2f(1.f - exp2f(-5.f - (float)head)));
        float s0 = 0.f, s1 = 0.f;
        const size_t base = ((size_t)(b * 64) * 4 + head) * 8192 + 2 * de;
        for (int n0 = 0; n0 < 64; n0 += 16) {
            f32x2 kv[16];
#pragma unroll
            for (int i = 0; i < 16; ++i) kv[i] = *(const f32x2*)(KV + base + (size_t)(n0 + i) * 32768);
#pragma unroll
            for (int i = 0; i < 16; ++i) { *(unsigned*)(ST + base + (size_t)(n0 + i) * 32768) = cvtpk(s0, s1); s0 = g * (s0 + kv[i][0]); s1 = g * (s1 + kv[i][1]); }
        }
    }
}
constexpr int FOX_BUF = 64 * KS * 2 + 256;
constexpr int FOX_SCR = 2 * FOX_BUF;
struct FoxRegs { u32x4 k, v; float c; };
__device__ __forceinline__ void fox_load(FoxRegs& R, const bf16_t* kg, const float* c2, int t, int tid) {
    R.k = *(const u32x4*)(kg + (size_t)t * 64 * ZP); R.v = *(const u32x4*)(kg + (size_t)t * 64 * ZP + (VF_OFF - KF_OFF)); R.c = (tid < 64) ? c2[64 * t + tid] : 0.f;
}
__device__ __forceinline__ void fox_store(const FoxRegs& R, LAS unsigned char* buf, int soff, int tid) {
    *(LAS u32x4*)(buf + soff) = R.k; *(LAS u32x4*)(buf + 64 * KS + soff) = R.v; if (tid < 64) *(LAS float*)(buf + 128 * KS + 4 * tid) = R.c;
}
__device__ __forceinline__ void fox_tile(const LAS unsigned char* Kb, const bf16x8 (&qr)[4], float cqs, bool band, int qrel, int kb0,
                                         f32x16& o0, f32x16& o1, f32x16& ol, int r, int h, int voff) {
    const LAS unsigned char* Vb = Kb + 64 * KS; const LAS float* ckb = (const LAS float*)(Kb + 128 * KS);
    f32x16 p0, p1;
#pragma unroll
    for (int g = 0; g < 4; ++g) { const f32x4 ca = *(const LAS f32x4*)(ckb + 8 * g + 4 * h), cb = *(const LAS f32x4*)(ckb + 32 + 8 * g + 4 * h);
#pragma unroll
        for (int j = 0; j < 4; ++j) { p0[4 * g + j] = cqs - ca[j]; p1[4 * g + j] = cqs - cb[j]; } }
    const LAS unsigned char* kb = Kb + r * KS + h * 16;
#pragma unroll
    for (int s = 0; s < 4; ++s) { const bf16x8 k0 = *(const LAS bf16x8*)(kb + s * 32), k1 = *(const LAS bf16x8*)(kb + 32 * KS + s * 32);
        p0 = MFMA32(k0, qr[s], p0); p1 = MFMA32(k1, qr[s], p1); }
    if (band) {
#pragma unroll
        for (int i = 0; i < 16; ++i) { const int kv = kb0 + (i & 3) + 8 * (i >> 2); if (kv > qrel) p0[i] = -INFINITY; if (kv + 32 > qrel) p1[i] = -INFINITY; } }
#pragma unroll
    for (int i = 0; i < 16; ++i) { p0[i] = __builtin_amdgcn_exp2f(p0[i]); p1[i] = __builtin_amdgcn_exp2f(p1[i]); }
    bf16x8 pf[4]; pf[0] = pack8(p0, 0); pf[1] = pack8(p0, 8); pf[2] = pack8(p1, 0); pf[3] = pack8(p1, 8);
    const bf16x8 ones = {0x3f80, 0x3f80, 0x3f80, 0x3f80, 0x3f80, 0x3f80, 0x3f80, 0x3f80};
    const LAS unsigned char* vb = Vb + voff;
#pragma unroll
    for (int ks = 0; ks < 4; ++ks) {
        const bf16x8 v0 = cat8(vtr(vb + (16 * ks) * KS), vtr(vb + (16 * ks + 8) * KS));
        const bf16x8 v1 = cat8(vtr(vb + (16 * ks) * KS + 64), vtr(vb + (16 * ks + 8) * KS + 64));
        o0 = MFMA32(pf[ks], v0, o0); o1 = MFMA32(pf[ks], v1, o1); ol = MFMA32(pf[ks], ones, ol);
    }
}
constexpr int FOX_TAB = 2 * FOX_BUF;
__device__ __forceinline__ void fox_phase(const Params& P, LAS unsigned char* lds) {
    const int tid = threadIdx.x, lane = tid & 63, w = __builtin_amdgcn_readfirstlane(tid >> 6), r = lane & 31, h = lane >> 5;
    const bf16_t* Z = (const bf16_t*)(P.ws + WS_Z); const float* Cc = (const float*)(P.ws + WS_C2); bf16_t* OM = (bf16_t*)(P.ws + WS_B);
    float mq = fabsf(P.g_fox_q[lane]), mk = fabsf(P.g_fox_k[lane]);
#pragma unroll
    for (int o = 1; o < 64; o <<= 1) { mq = fmaxf(mq, __shfl_xor(mq, o)); mk = fmaxf(mk, __shfl_xor(mk, o)); }
    const float smax2 = 8.f * mq * mk * LOG2E * 1.02f + 0.25f;
    const float thr = -64.f - 2.f * smax2;
    const int srow = tid >> 3, sch = tid & 7; const int soff = srow * KS + sch * 16;
    const int q4 = (lane & 15) >> 2, p4 = lane & 3, g16 = (lane >> 4) & 1;
    const int voff = (4 * h + q4) * KS + g16 * 32 + p4 * 8;
    const int G = gridDim.x; const int nu = (2048 - (int)blockIdx.x + G - 1) / G;
    LAS int* tab = (LAS int*)(lds + FOX_TAB);
#define FOX_UNIT(i, qb, b, hd) const int u_ = (int)blockIdx.x + (i) * G; const int qb = u_ & 31, b = (u_ >> 5) & 7, hd = u_ >> 8
    for (int i = w; i < nu; i += 8) {
        FOX_UNIT(i, qb, b, hd); const float* c2 = Cc + (size_t)(b * 8 + hd) * SEQ; const float cq0 = c2[qb * 256];
        const int t1 = lane, t2 = lane + 64;
        const bool e1 = (t1 < 4 * qb) && (cq0 - c2[64 * t1 + 63] <= thr);
        const bool e2 = (t2 < 4 * qb) && (cq0 - c2[64 * t2 + 63] <= thr);
        const int t0 = __popcll(__ballot(e1)) + __popcll(__ballot(e2));
        if (lane == 0) { tab[i] = t0; tab[16 + i] = 4 * qb + 4; }
    }
    __syncthreads();
#define FOX_T0(i) __builtin_amdgcn_readfirstlane(tab[i])
#define FOX_NT(i) __builtin_amdgcn_readfirstlane(tab[16 + (i)])
#define FOX_ADV(pi, pt) do { ++pt; if (pt >= FOX_NT(pi)) { ++pi; pt = (pi < nu) ? FOX_T0(pi) : 0; } } while (0)
#define FOX_LOAD(R, pi, pt) do { FOX_UNIT(pi, qb_, b_, hd_); (void)qb_; \
        fox_load(R, Z + ((size_t)b_ * SEQ + srow) * ZP + KF_OFF + hd_ * 64 + 8 * sch, Cc + (size_t)(b_ * 8 + hd_) * SEQ, pt, tid); } while (0)
#define FOX_QLOAD(pi) do { FOX_UNIT(pi, qb_, b_, hd_); const bf16_t* qp_ = Z + ((size_t)b_ * SEQ + qb_ * 256 + 32 * w + r) * ZP + QF_OFF + hd_ * 64 + 8 * h; \
        _Pragma("unroll") for (int s_ = 0; s_ < 4; ++s_) qn[s_] = *(const bf16x8*)(qp_ + 16 * s_); \
        cqn = Cc[(size_t)(b_ * 8 + hd_) * SEQ + qb_ * 256 + 32 * w + r] - smax2; } while (0)
    if (nu > 0) {
        int ci = 0, ct = FOX_T0(0); int n1i = ci, n1t = ct; FOX_ADV(n1i, n1t); int n2i = n1i, n2t = n1t; if (n2i < nu) FOX_ADV(n2i, n2t);
        FoxRegs RA, RB; bf16x8 qn[4], qr[4]; float cqn, cqs = 0.f;
        FOX_LOAD(RA, ci, ct);
        if (n1i < nu) FOX_LOAD(RB, n1i, n1t);
        FOX_QLOAD(0);
        fox_store(RA, lds, soff, tid);
        __syncthreads();
        f32x16 o0, o1, ol;
#define FOX_ITER(RL, RS, bc, bn) do { \
            if (n2i < nu) FOX_LOAD(RL, n2i, n2t); \
            FOX_UNIT(ci, qb, b, hd); const int q0 = qb * 256; \
            if (ct == FOX_T0(ci)) { _Pragma("unroll") for (int i_ = 0; i_ < 16; ++i_) { o0[i_] = 0.f; o1[i_] = 0.f; ol[i_] = 0.f; } \
                _Pragma("unroll") for (int s_ = 0; s_ < 4; ++s_) qr[s_] = qn[s_]; cqs = cqn; } \
            if (n1i < nu && n1i != ci) FOX_QLOAD(n1i); \
            if (64 * ct <= q0 + 32 * w + 31) fox_tile(lds + (bc) * FOX_BUF, qr, cqs, ct >= 4 * qb, 32 * w + r, 64 * (ct - 4 * qb) + 4 * h, o0, o1, ol, r, h, voff); \
            if (n1i < nu) fox_store(RS, lds + (bn) * FOX_BUF, soff, tid); \
            if (ct == 4 * qb + 3) { bf16_t* op = OM + ((size_t)b * SEQ + q0 + 32 * w) * DM + 512 + hd * 64 + r; \
                _Pragma("unroll") for (int i_ = 0; i_ < 16; ++i_) { const float a_ = __builtin_amdgcn_rcpf(ol[i_]); const int row_ = crow(i_, h); \
                    op[(size_t)row_ * DM] = (bf16_t)(cvtpk(o0[i_] * a_, 0.f) & 0xffffu); op[(size_t)row_ * DM + 32] = (bf16_t)(cvtpk(o1[i_] * a_, 0.f) & 0xffffu); } } \
            __syncthreads(); \
            ci = n1i; ct = n1t; n1i = n2i; n1t = n2t; if (n2i < nu) FOX_ADV(n2i, n2t); } while (0)
        while (ci < nu) {
            FOX_ITER(RA, RB, 0, 1);
            if (ci < nu) FOX_ITER(RB, RA, 1, 0);
        }
#undef FOX_ITER
    }
#undef FOX_UNIT
#undef FOX_T0
#undef FOX_NT
#undef FOX_ADV
#undef FOX_LOAD
#undef FOX_QLOAD
    __syncthreads();
}
__device__ __forceinline__ void ret_out_phase(const Params& P, LAS unsigned char* lds) {
    const int tid = threadIdx.x, lane = tid & 63, w = __builtin_amdgcn_readfirstlane(tid >> 6), r = lane & 31, h = lane >> 5;
    const int q4 = (lane & 15) >> 2, p4 = lane & 3, g16 = (lane >> 4) & 1;
    const bf16_t* Z = (const bf16_t*)(P.ws + WS_Z); const bf16_t* ST = (const bf16_t*)(P.ws + WS_A + 64 * MiB); bf16_t* OM = (bf16_t*)(P.ws + WS_B);
    constexpr int HB = 128 * KS + 128 * VS + 64 * VS;
    for (int u = blockIdx.x; u < 1024; u += gridDim.x) {
        const int b = u >> 7, n = (u >> 1) & 63, hp = u & 1; const size_t R0 = (size_t)b * SEQ + (size_t)n * 128;
#pragma unroll
        for (int i = 0; i < 4; ++i) { const int id = tid + 512 * i; const int hh = id >> 10, row = (id >> 3) & 127, ch = id & 7;
            const u32x4 v = *(const u32x4*)(Z + (R0 + row) * ZP + KR_OFF + (2 * hp + hh) * 64 + 8 * ch);
            *(LAS u32x4*)(lds + hh * HB + row * KS + ch * 16) = v; }
#pragma unroll
        for (int i = 0; i < 8; ++i) { const int id = tid + 512 * i; const int hh = id >> 11, row = (id >> 4) & 127, ch = id & 15;
            const u32x4 v = *(const u32x4*)(Z + (R0 + row) * ZP + VR_OFF + (2 * hp + hh) * 128 + 8 * ch);
            *(LAS u32x4*)(lds + hh * HB + 128 * KS + row * VS + ch * 16) = v; }
#pragma unroll
        for (int i = 0; i < 4; ++i) { const int id = tid + 512 * i; const int hh = id >> 10, row = (id >> 4) & 63, ch = id & 15;
            const u32x4 v = *(const u32x4*)(ST + ((size_t)((b * 64 + n) * 4 + 2 * hp + hh)) * 8192 + row * 128 + 8 * ch);
            *(LAS u32x4*)(lds + hh * HB + 128 * KS + 128 * VS + row * VS + ch * 16) = v; }
        const int hh = w >> 2, wq = w & 3, head = 2 * hp + hh;
        const bf16_t* qp = Z + (R0 + 32 * wq + r) * ZP + QR_OFF + head * 64 + 8 * h;
        bf16x8 qr[4];
#pragma unroll
        for (int s = 0; s < 4; ++s) qr[s] = *(const bf16x8*)(qp + 16 * s);
        __syncthreads();
        const LAS unsigned char* Kt = lds + hh * HB; const LAS unsigned char* Vt = Kt + 128 * KS; const LAS unsigned char* Sp = Vt + 128 * VS;
        f32x16 o[4];
#pragma unroll
        for (int e = 0; e < 4; ++e)
#pragma unroll
            for (int i = 0; i < 16; ++i) o[e][i] = 0.f;
        const int coff = (16 * g16 + 4 * p4) * 2;
        for (int jb = 0; jb <= wq; ++jb) {
            f32x16 p;
#pragma unroll
            for (int i = 0; i < 16; ++i) p[i] = 0.f;
            const LAS unsigned char* kb = Kt + (32 * jb + r) * KS + h * 16;
#pragma unroll
            for (int s = 0; s < 4; ++s) p = MFMA32(*(const LAS bf16x8*)(kb + s * 32), qr[s], p);
            if (jb == wq) {
#pragma unroll
                for (int i = 0; i < 16; ++i) if (crow(i, h) > r) p[i] = 0.f;
            }
            const bf16x8 pf0 = pack8(p, 0), pf1 = pack8(p, 8);
            const LAS unsigned char* vb = Vt + (32 * jb + 4 * h + q4) * VS + coff;
#pragma unroll
            for (int e = 0; e < 4; ++e) {
                const bf16x8 v0 = cat8(vtr(vb + e * 64), vtr(vb + 8 * VS + e * 64));
                const bf16x8 v1 = cat8(vtr(vb + 16 * VS + e * 64), vtr(vb + 24 * VS + e * 64));
                o[e] = MFMA32(pf0, v0, o[e]); o[e] = MFMA32(pf1, v1, o[e]);
            }
        }
        { const LAS unsigned char* sb = Sp + (8 * h + q4) * VS + coff;
#pragma unroll
          for (int s = 0; s < 4; ++s)
#pragma unroll
              for (int e = 0; e < 4; ++e) { const bf16x8 sf = cat8(vtr(sb + (16 * s) * VS + e * 64), vtr(sb + (16 * s + 4) * VS + e * 64)); o[e] = MFMA32(qr[s], sf, o[e]); } }
        float gn[4];
#pragma unroll
        for (int e = 0; e < 4; ++e) gn[e] = P.g_ret_norm[head * 128 + 32 * e + r];
#pragma unroll
        for (int i = 0; i < 16; ++i) {
            float s1 = (o[0][i] + o[1][i]) + (o[2][i] + o[3][i]);
            float s2 = (o[0][i] * o[0][i] + o[1][i] * o[1][i]) + (o[2][i] * o[2][i] + o[3][i] * o[3][i]);
#pragma unroll
            for (int x = 1; x < 32; x <<= 1) { s1 += __shfl_xor(s1, x); s2 += __shfl_xor(s2, x); }
            const float mu = s1 * (1.f / 128.f); const float var = fmaxf(s2 * (1.f / 128.f) - mu * mu, 0.f); const float rs = rsqrtf(var + EPS);
            const size_t row = R0 + 32 * wq + crow(i, h);
            const bf16_t* gp = Z + row * ZP + GR_OFF + head * 128 + r; bf16_t* op = OM + row * DM + head * 128 + r;
#pragma unroll
            for (int e = 0; e < 4; ++e) { const float gt = __uint_as_float((unsigned)gp[32 * e] << 16); op[32 * e] = (bf16_t)(cvtpk((o[e][i] - mu) * rs * gn[e] * gt, 0.f) & 0xffffu); }
        }
        __syncthreads();
    }
}


#define XB_TMO      128
#define XB_XCNT(j)  (256  + 64 * (j))
#define XB_XSUB(j)  (1280 + 64 * (j))
#define XB_XGEN(j)  (2304 + 64 * (j))
#define XB_TOP      3328
#define XB_TOPGEN   3392
#define XCD_BAR_WORDS 3456
#define XB_SPIN_CAP (1u << 18)
__device__ __forceinline__ unsigned xb_ld(unsigned* p)              { return __hip_atomic_load(p, __ATOMIC_RELAXED, __HIP_MEMORY_SCOPE_AGENT); }
__device__ __forceinline__ unsigned xb_add(unsigned* p, unsigned v) { return __hip_atomic_fetch_add(p, v, __ATOMIC_RELAXED, __HIP_MEMORY_SCOPE_AGENT); }
__device__ __forceinline__ unsigned xb_xcc_id() { return (unsigned)__builtin_amdgcn_s_getreg((3 << 11) | 20) & 0xFu; }
#define XB_SPIN(cond, bar) do { unsigned _sp = 0; while (cond) { __builtin_amdgcn_s_sleep(1); \
    if ((++_sp & 255u) == 0u) { if (xb_ld(&(bar)[XB_TMO])) break; if (_sp > XB_SPIN_CAP) { atomicAdd(&(bar)[XB_TMO], 1u); break; } } } } while (0)
struct XcdBarrier { unsigned* bar; unsigned x; volatile LAS unsigned* st; };
__device__ __forceinline__ XcdBarrier xcd_barrier_post(unsigned* bar, volatile LAS unsigned* st) {
    XcdBarrier b; b.bar = bar; b.x = xb_xcc_id(); b.st = st;
    if (threadIdx.x == 0) (void)xb_add(&bar[XB_XCNT(b.x)], 1u);
    return b;
}
__device__ __forceinline__ void xcd_barrier_complete(unsigned* bar, unsigned x, unsigned& nloc, unsigned& nx) {
    const unsigned G = gridDim.x * gridDim.y * gridDim.z;
    unsigned sum, cnt, mine, sp = 0u;
    for (;;) {
        sum = 0u; cnt = 0u; mine = 0u;
#pragma unroll
        for (unsigned j = 0; j < 16; ++j) { const unsigned c = xb_ld(&bar[XB_XCNT(j)]); sum += c; cnt += (c > 0u) ? 1u : 0u; mine = (j == x) ? c : mine; }
        if (sum == G) break;
        __builtin_amdgcn_s_sleep(1);
        if ((++sp & 255u) == 0u) { if (xb_ld(&bar[XB_TMO])) break; if (sp > XB_SPIN_CAP) { atomicAdd(&bar[XB_TMO], 1u); break; } }
    }
    nloc = mine > 0u ? mine : 1u; nx = cnt > 0u ? cnt : 1u;
}
__device__ __forceinline__ void xcd_barrier(const XcdBarrier& b) {
    asm volatile("s_waitcnt vmcnt(0)" ::: "memory");
    __syncthreads();
    if (threadIdx.x == 0) {
        unsigned* bar = b.bar;
        __builtin_amdgcn_s_waitcnt(0);
        unsigned nloc = b.st[0], nx = b.st[1];
        if (nloc == 0u) { xcd_barrier_complete(bar, b.x, nloc, nx); b.st[0] = nloc; b.st[1] = nx; }
        const unsigned old = xb_add(&bar[XB_XSUB(b.x)], 1u);
        const unsigned gen = old / nloc;
        if (old + 1u == (gen + 1u) * nloc) {
            __builtin_amdgcn_fence(__ATOMIC_RELEASE, "agent");
            asm volatile("s_waitcnt vmcnt(0)" ::: "memory");
            const unsigned og = xb_add(&bar[XB_TOP], 1u);
            const unsigned tg = og / nx;
            if (og + 1u == (tg + 1u) * nx) xb_add(&bar[XB_TOPGEN], 1u);
            else XB_SPIN(xb_ld(&bar[XB_TOPGEN]) == tg, bar);
            __builtin_amdgcn_fence(__ATOMIC_ACQUIRE, "agent");
            xb_add(&bar[XB_XGEN(b.x)], 1u);
            asm volatile("s_waitcnt vmcnt(0)" ::: "memory");
        } else {
            XB_SPIN(xb_ld(&bar[XB_XGEN(b.x)]) == gen, bar);
            __builtin_amdgcn_fence(__ATOMIC_ACQUIRE, "agent");
            asm volatile("s_waitcnt vmcnt(0)" ::: "memory");
        }
    }
    __syncthreads();
}
#ifndef STAG_TICKS
#define STAG_TICKS 0
#endif
__device__ __forceinline__ void stagger_delay() {
    const int ticks = (int)(blockIdx.x & 7) * STAG_TICKS;
    if (ticks > 0) { const unsigned long long t0 = __builtin_amdgcn_s_memrealtime(); while (__builtin_amdgcn_s_memrealtime() - t0 < (unsigned long long)ticks) __builtin_amdgcn_s_sleep(8); }
}
constexpr int NPHASE = 9;
__global__ void __launch_bounds__(512, 2) fwd_megakernel(Params P) {
    extern __shared__ __attribute__((aligned(16))) unsigned char lds_raw[];
    LAS unsigned char* lds = (LAS unsigned char*)lds_raw;
    cg::grid_group grid = cg::this_grid();
    unsigned char* ws = P.ws; const int lo = P.ph_lo, hi = P.ph_hi; const int G = gridDim.x;
    if (lo < 0) grid.sync();
    volatile LAS unsigned* misc = (volatile LAS unsigned*)(lds + LDS_MISC);
    if (threadIdx.x < 16) misc[threadIdx.x] = 0u;
    __syncthreads();
    XcdBarrier bar; bar.bar = (unsigned*)(ws + WS_CTL); bar.x = 0; bar.st = misc;
    if (hi - lo > 1) bar = xcd_barrier_post((unsigned*)(ws + WS_CTL), misc);
#ifndef PH_MASK
#define PH_MASK 0x1ff
#endif
#define IN(k) (((PH_MASK >> (k)) & 1) && lo <= (k) && (k) < hi)
#ifndef REP_MASK
#define REP_MASK 0
#endif
#define REPS(k) for (int rep_ = 0; rep_ < 1 + ((REP_MASK >> (k)) & 1); ++rep_)
#define SEAM(k) do { if (IN(k) && IN((k) + 1)) xcd_barrier(bar); } while (0)
    if (IN(0)) REPS(0) { p0_prologue(P, lds); __syncthreads(); }
    SEAM(0);
    if (IN(1)) REPS(1) {
        cumsum_c2(P, lds); __syncthreads();
        pg8::Gemm g{(const bf16_t*)(ws + WS_A), (const bf16_t*)(ws + WS_WIN), M, ZP, DM, DM, DM}; pg8::StaticOrder S; S.init(M, ZP, G, (int)blockIdx.x);
        EpiZ E{(bf16_t*)(ws + WS_Z), (const float*)(ws + WS_ROPE), P.g_fox_q, P.g_fox_k};
        stagger_delay(); pg8::gemm_phase<EpiZ, pg8::StaticOrder>(lds, g, S, E);
    }
    SEAM(1);
    if (IN(2)) REPS(2) { ret_kv_phase(P, lds); }
    SEAM(2);
    if (IN(3)) REPS(3) { ret_scan(P); fox_phase(P, lds); }
    SEAM(3);
    if (IN(4)) REPS(4) { ret_out_phase(P, lds); }
    SEAM(4);
    if (IN(5)) REPS(5) {
        pg8::Gemm g{(const bf16_t*)(ws + WS_B), (const bf16_t*)(ws + WS_WCAT), M, DM, 512, DM, DM}; pg8::PairOrder S; S.base.init(M, DM, G, (int)blockIdx.x); S.khalf = 512;
        EpiMerge E{(const bf16_t*)(ws + WS_Z), (bf16_t*)(ws + WS_A)};
        stagger_delay(); pg8::gemm_phase<EpiMerge, pg8::PairOrder>(lds, g, S, E);
    }
    SEAM(5);
    if (IN(6)) REPS(6) {
        pg8::Gemm g{(const bf16_t*)(ws + WS_A), (const bf16_t*)(ws + WS_WOUT), M, DM, DM, DM, DM}; pg8::StaticOrder S; S.init(M, DM, G, (int)blockIdx.x);
        EpiOut E{P.x, (bf16_t*)(ws + WS_B), (float*)(ws + WS_SSQ)};
        stagger_delay(); pg8::gemm_phase<EpiOut, pg8::StaticOrder>(lds, g, S, E);
    }
    SEAM(6);
    if (IN(7)) REPS(7) {
        pg8::Gemm g{(const bf16_t*)(ws + WS_B), (const bf16_t*)(ws + WS_WGU), M, 2 * DFF, DM, DM, DM}; pg8::StaticOrder S; S.init(M, 2 * DFF, G, (int)blockIdx.x);
        EpiGU E{(const float*)(ws + WS_SSQ), (bf16_t*)(ws + WS_Z)};
        stagger_delay(); pg8::gemm_phase<EpiGU, pg8::StaticOrder>(lds, g, S, E);
    }
    SEAM(7);
    if (IN(8)) {
        pg8::Gemm g{(const bf16_t*)(ws + WS_Z), (const bf16_t*)(ws + WS_WDN), M, DM, DFF, DFF, DFF}; pg8::StaticOrder S; S.init(M, DM, G, (int)blockIdx.x);
        EpiDown E{(const bf16_t*)(ws + WS_B), P.out};
        stagger_delay(); pg8::gemm_phase<EpiDown, pg8::StaticOrder>(lds, g, S, E);
    }
#undef IN
#undef SEAM
}

extern "C" void kernel_launch(void* const* d_in, const int* in_sizes, int n_in, void* d_out, int out_size, void* d_ws, size_t ws_size, hipStream_t stream) {
    static int grid = 0;
    if (grid == 0) {
        if (n_in != 14 || in_sizes[0] != M * DM || out_size != M * DM || ws_size < WS_END) { fprintf(stderr, "kernel_launch: unexpected shapes (n_in %d, ws %zu)\n", n_in, ws_size); grid = -1; return; }
        int dev = 0, cus = 0, per_cu = 0;
        (void)hipGetDevice(&dev); (void)hipDeviceGetAttribute(&cus, hipDeviceAttributeMultiprocessorCount, dev);
        (void)hipFuncSetAttribute((const void*)fwd_megakernel, hipFuncAttributeMaxDynamicSharedMemorySize, LDS_BYTES);
        (void)hipOccupancyMaxActiveBlocksPerMultiprocessor(&per_cu, (const void*)fwd_megakernel, 512, LDS_BYTES);
        if (per_cu < 1) per_cu = 1;
        grid = cus * per_cu; (void)hipGetLastError();
    }
    if (grid < 0) return;
    if (hipMemsetAsync((char*)d_ws + WS_CTL, 0, CTL_BYTES, stream) != hipSuccess) { fprintf(stderr, "kernel_launch: memset failed\n"); return; }
    Params p{};
    p.x = (const float*)d_in[0]; p.g_mix = (const float*)d_in[1]; p.w_in = (const float*)d_in[2]; p.b_forget = (const float*)d_in[3]; p.g_ret_norm = (const float*)d_in[4];
    p.w_ret_o = (const float*)d_in[5]; p.g_fox_q = (const float*)d_in[6]; p.g_fox_k = (const float*)d_in[7]; p.w_fox_o = (const float*)d_in[8]; p.w_out = (const float*)d_in[9];
    p.g_ffn = (const float*)d_in[10]; p.w_gate = (const float*)d_in[11]; p.w_up = (const float*)d_in[12]; p.w_down = (const float*)d_in[13];
    p.out = (float*)d_out; p.ws = (unsigned char*)d_ws;
#if MK_N_LAUNCHES == 1
    p.ph_lo = 0; p.ph_hi = NPHASE;
    void* args[] = {&p};
    hipError_t e = hipLaunchCooperativeKernel((const void*)fwd_megakernel, dim3(grid), dim3(512), args, LDS_BYTES, stream);
    if (e != hipSuccess) fprintf(stderr, "cooperative launch failed: %s (grid %d)\n", hipGetErrorString(e), grid);
#else
    for (int k = 0; k < NPHASE; ++k) { p.ph_lo = k; p.ph_hi = k + 1; hipLaunchKernelGGL(fwd_megakernel, dim3(grid), dim3(512), LDS_BYTES, stream, p); }
#endif
}
```
